# Optimizing an MI355X kernel written in HIP

```python
import math
import jax, jax.numpy as jnp
from jax import lax
import numpy as np

D_MODEL = 2048
BATCH = 4
SEQ = 2048
DEPTH = 1

CHUNK = 64
Q_BLOCK = 128
D_MIX = D_MODEL
SSM_WIDTH = D_MIX // 2
SSM_GROUP = 16
SSM_GROUPS = SSM_WIDTH // SSM_GROUP
SSM_STATE = 64
N_HEADS = 8
QK_NOPE = 128
QK_ROPE = 64
QK_HEAD = QK_NOPE + QK_ROPE
V_HEAD = 128
ATTN_WIDTH = N_HEADS * V_HEAD
Q_LORA = 512
KV_LORA = 256
D_IN = SSM_WIDTH + Q_LORA + KV_LORA + QK_ROPE
D_FF = 5632
ROPE_THETA = 10000.0
EPS = 1e-6
STEP_MIN = 1e-3
STEP_MAX = 1e-1

kernel_name = "hymba_s5_mla_macaron_block"


def rms_norm(x, g):
    xf = x.astype(jnp.float32)
    y = xf * lax.rsqrt(jnp.mean(xf * xf, axis=-1, keepdims=True) + EPS)
    return (y * g.astype(jnp.float32)).astype(x.dtype)


def swiglu(h, w_gate, w_up, w_down):
    return (jax.nn.silu(h @ w_gate) * (h @ w_up)) @ w_down


def rope(x, cos, sin):
    half = x.shape[-1] // 2
    x1, x2 = x[..., :half], x[..., half:]
    return jnp.concatenate([x1 * cos - x2 * sin, x2 * cos + x1 * sin], axis=-1)


def s5_mixer(u, log_step, a_re, a_im, b_re, b_im, c_re, c_im, d_skip, w_glu, b_glu):
    f32 = jnp.float32
    bsz, seq, _ = u.shape
    uf = u.astype(f32).reshape(bsz, seq, SSM_GROUPS, SSM_GROUP)
    dt = jnp.exp(log_step.astype(f32))[:, None]
    ar, ai = a_re.astype(f32), a_im.astype(f32)
    mag = jnp.exp(ar * dt)
    ang = ai * dt
    lr, li = mag * jnp.cos(ang), mag * jnp.sin(ang)
    den = ar * ar + ai * ai
    fr = ((lr - 1.0) * ar + li * ai) / den
    fi = (li * ar - (lr - 1.0) * ai) / den
    bu_r = jnp.einsum('blgc,gnc->blgn', uf, b_re.astype(f32))
    bu_i = jnp.einsum('blgc,gnc->blgn', uf, b_im.astype(f32))
    br = fr * bu_r - fi * bu_i
    bi = fr * bu_i + fi * bu_r
    lr_t = jnp.broadcast_to(lr, (1, seq, SSM_GROUPS, SSM_STATE))
    li_t = jnp.broadcast_to(li, (1, seq, SSM_GROUPS, SSM_STATE))

    def combine(e1, e2):
        a1r, a1i, b1r, b1i = e1
        a2r, a2i, b2r, b2i = e2
        return (a2r * a1r - a2i * a1i,
                a2r * a1i + a2i * a1r,
                a2r * b1r - a2i * b1i + b2r,
                a2r * b1i + a2i * b1r + b2i)

    _, _, sr, si = lax.associative_scan(combine, (lr_t, li_t, br, bi), axis=1)
    y = (jnp.einsum('blgn,gcn->blgc', sr, c_re.astype(f32))
         - jnp.einsum('blgn,gcn->blgc', si, c_im.astype(f32))
         + d_skip.astype(f32) * uf)
    y = jax.nn.gelu(y.reshape(bsz, seq, SSM_WIDTH))
    y = y * jax.nn.sigmoid(y @ w_glu.astype(f32) + b_glu.astype(f32))
    return y.astype(u.dtype)


def mla_mixer(q_lat, kv_lat, k_pe, cos, sin, q_a_norm, w_q_up, kv_a_norm, w_kv_up, q_norm, k_norm):
    bsz, seq, _ = q_lat.shape
    q = (rms_norm(q_lat, q_a_norm) @ w_q_up).reshape(bsz, seq, N_HEADS, QK_HEAD)
    kv = (rms_norm(kv_lat, kv_a_norm) @ w_kv_up).reshape(bsz, seq, N_HEADS, QK_NOPE + V_HEAD)
    k_nope, v = kv[..., :QK_NOPE], kv[..., QK_NOPE:]
    k = jnp.concatenate(
        [k_nope, jnp.broadcast_to(k_pe[:, :, None, :], (bsz, seq, N_HEADS, QK_ROPE))], axis=-1)
    q = rms_norm(q, q_norm)
    k = rms_norm(k, k_norm)
    cos_c, sin_c = cos.astype(q.dtype), sin.astype(q.dtype)
    q = jnp.concatenate([q[..., :QK_NOPE], rope(q[..., QK_NOPE:], cos_c, sin_c)], axis=-1)
    k = jnp.concatenate([k[..., :QK_NOPE], rope(k[..., QK_NOPE:], cos_c, sin_c)], axis=-1)
    q = q.transpose(0, 2, 1, 3)
    k = k.transpose(0, 2, 1, 3)
    v = v.transpose(0, 2, 1, 3)
    scale = QK_HEAD ** -0.5
    outs = []
    for i in range(seq // Q_BLOCK):
        q0 = i * Q_BLOCK
        k_end = q0 + Q_BLOCK
        s = jnp.einsum('bhqd,bhkd->bhqk', q[:, :, q0:k_end], k[:, :, :k_end]).astype(jnp.float32) * scale
        q_chunk = (q0 + jnp.arange(Q_BLOCK)) // CHUNK
        k_chunk = jnp.arange(k_end) // CHUNK
        s = jnp.where(k_chunk[None, :] <= q_chunk[:, None], s, -jnp.inf)
        p = jax.nn.softmax(s, axis=-1).astype(v.dtype)
        outs.append(jnp.einsum('bhqk,bhkd->bhqd', p, v[:, :, :k_end]))
    o = jnp.concatenate(outs, axis=2)
    return o.transpose(0, 2, 1, 3).reshape(bsz, seq, ATTN_WIDTH)


def setup_inputs(seed: int = 0) -> dict:
    key = jax.random.key(seed)
    ks = jax.random.split(key, 40)
    f32 = jnp.float32

    def dense(k, fan_in, fan_out):
        return jax.random.normal(k, (DEPTH, fan_in, fan_out), f32) * fan_in ** -0.5

    def gain(k, n):
        return 1.0 + 0.01 * jax.random.normal(k, (DEPTH, n), f32)

    G, N, C = SSM_GROUPS, SSM_STATE, SSM_GROUP
    x = jax.random.normal(ks[0], (BATCH, SEQ, D_MODEL), f32)
    offsets = jax.random.randint(ks[1], (BATCH, 1), 0, 4096, dtype=jnp.int32)
    positions = (offsets + jnp.arange(SEQ, dtype=jnp.int32)[None, :]).astype(jnp.int32)
    return {
        "x": x,
        "positions": positions,
        "ffn1_norm": gain(ks[2], D_MODEL),
        "ffn1_w_gate": dense(ks[3], D_MODEL, D_FF),
        "ffn1_w_up": dense(ks[4], D_MODEL, D_FF),
        "ffn1_w_down": dense(ks[5], D_FF, D_MODEL),
        "mix_norm": gain(ks[6], D_MODEL),
        "w_in": dense(ks[7], D_MODEL, D_IN),
        "ssm_log_step": jax.random.uniform(ks[8], (DEPTH, G), f32,
                                           minval=math.log(STEP_MIN), maxval=math.log(STEP_MAX)),
        "ssm_a_re": -0.5 + 0.01 * jax.random.normal(ks[9], (DEPTH, G, N), f32),
        "ssm_a_im": math.pi * jnp.arange(N, dtype=f32)[None, None, :]
                    + 0.01 * jax.random.normal(ks[10], (DEPTH, G, N), f32),
        "ssm_b_re": jax.random.normal(ks[11], (DEPTH, G, N, C), f32) * (2 * C) ** -0.5,
        "ssm_b_im": jax.random.normal(ks[12], (DEPTH, G, N, C), f32) * (2 * C) ** -0.5,
        "ssm_c_re": jax.random.normal(ks[13], (DEPTH, G, C, N), f32) * (2 * N) ** -0.5,
        "ssm_c_im": jax.random.normal(ks[14], (DEPTH, G, C, N), f32) * (2 * N) ** -0.5,
        "ssm_d": jax.random.normal(ks[15], (DEPTH, G, C), f32),
        "ssm_w_glu": dense(ks[16], SSM_WIDTH, SSM_WIDTH),
        "ssm_b_glu": 0.01 * jax.random.normal(ks[17], (DEPTH, SSM_WIDTH), f32),
        "mla_q_a_norm": gain(ks[18], Q_LORA),
        "mla_w_q_up": dense(ks[19], Q_LORA, N_HEADS * QK_HEAD),
        "mla_kv_a_norm": gain(ks[20], KV_LORA),
        "mla_w_kv_up": dense(ks[21], KV_LORA, N_HEADS * (QK_NOPE + V_HEAD)),
        "mla_q_norm": gain(ks[22], QK_HEAD),
        "mla_k_norm": gain(ks[23], QK_HEAD),
        "ssm_out_norm": gain(ks[24], SSM_WIDTH),
        "attn_out_norm": gain(ks[25], ATTN_WIDTH),
        "w_out": dense(ks[26], D_MIX, D_MODEL),
        "ffn2_norm": gain(ks[27], D_MODEL),
        "ffn2_w_gate": dense(ks[28], D_MODEL, D_FF),
        "ffn2_w_up": dense(ks[29], D_MODEL, D_FF),
        "ffn2_w_down": dense(ks[30], D_FF, D_MODEL),
        "final_norm": gain(ks[31], D_MODEL),
    }


def reference(x, positions, ffn1_norm, ffn1_w_gate, ffn1_w_up, ffn1_w_down, mix_norm, w_in,
              ssm_log_step, ssm_a_re, ssm_a_im, ssm_b_re, ssm_b_im, ssm_c_re, ssm_c_im, ssm_d,
              ssm_w_glu, ssm_b_glu, mla_q_a_norm, mla_w_q_up, mla_kv_a_norm, mla_w_kv_up,
              mla_q_norm, mla_k_norm, ssm_out_norm, attn_out_norm, w_out,
              ffn2_norm, ffn2_w_gate, ffn2_w_up, ffn2_w_down, final_norm):
    inv_freq = ROPE_THETA ** (-jnp.arange(0, QK_ROPE, 2, dtype=jnp.float32) / QK_ROPE)
    ang = positions.astype(jnp.float32)[..., None] * inv_freq
    cos = jnp.cos(ang)[:, :, None, :]
    sin = jnp.sin(ang)[:, :, None, :]
    o1 = SSM_WIDTH
    o2 = o1 + Q_LORA
    o3 = o2 + KV_LORA
    for l in range(DEPTH):
        x = x + 0.5 * swiglu(rms_norm(x, ffn1_norm[l]), ffn1_w_gate[l], ffn1_w_up[l], ffn1_w_down[l])
        z = rms_norm(x, mix_norm[l]) @ w_in[l]
        y_ssm = s5_mixer(z[..., :o1], ssm_log_step[l], ssm_a_re[l], ssm_a_im[l], ssm_b_re[l],
                         ssm_b_im[l], ssm_c_re[l], ssm_c_im[l], ssm_d[l], ssm_w_glu[l], ssm_b_glu[l])
        y_att = mla_mixer(z[..., o1:o2], z[..., o2:o3], z[..., o3:], cos, sin,
                          mla_q_a_norm[l], mla_w_q_up[l], mla_kv_a_norm[l], mla_w_kv_up[l],
                          mla_q_norm[l], mla_k_norm[l])
        y = jnp.concatenate([rms_norm(y_ssm, ssm_out_norm[l]), rms_norm(y_att, attn_out_norm[l])], axis=-1)
        x = x + y @ w_out[l]
        x = x + 0.5 * swiglu(rms_norm(x, ffn2_norm[l]), ffn2_w_gate[l], ffn2_w_up[l], ffn2_w_down[l])
        x = rms_norm(x, final_norm[l])
    return x
```

```cpp
#include <hip/hip_runtime.h>
#include <math.h>

namespace nv {
constexpr int DM = 2048, NB = 4, SEQ = 2048, DFF = 5632, DIN = 1856, SSMW = 1024, NG = 64, NS = 64, GC = 16;
constexpr int NH = 8, QKN = 128, QKR = 64, QKH = 192, VH = 128, ATTW = 1024, QL = 512, KVL = 256;
constexpr float EPS = 1e-6f;

__global__ void __launch_bounds__(256) rmsnorm_k(const float* in, int ldi, const float* g, float* out, int ldo, int W) {
    __shared__ float red[256];
    const int row = blockIdx.x, tid = threadIdx.x;
    const float* p = in + (size_t)row * ldi;
    float s = 0.f;
    for (int i = tid; i < W; i += 256) { float v = p[i]; s += v * v; }
    red[tid] = s; __syncthreads();
    for (int o = 128; o > 0; o >>= 1) { if (tid < o) red[tid] += red[tid + o]; __syncthreads(); }
    const float rs = rsqrtf(red[0] / (float)W + EPS);
    float* q = out + (size_t)row * ldo;
    for (int i = tid; i < W; i += 256) q[i] = p[i] * rs * g[i];
}

template <int MODE>
__global__ void __launch_bounds__(256) gemm_k(const float* A, int lda, const float* B, const float* B2, int ldb, float* C, int ldc, int K,
                                              const float* R, int ldr, float alpha, const float* bias) {
    __shared__ float As[16][132];
    __shared__ float Bs[16][64];
    __shared__ float Bs2[MODE == 2 ? 16 : 1][64];
    const int tid = threadIdx.x, tx = tid & 15, ty = tid >> 4;
    const int m0 = blockIdx.y * 128, n0 = blockIdx.x * 64;
    float acc[8][4], acc2[MODE == 2 ? 8 : 1][4];
#pragma unroll
    for (int i = 0; i < 8; ++i)
#pragma unroll
        for (int j = 0; j < 4; ++j) acc[i][j] = 0.f;
    if (MODE == 2) {
#pragma unroll
        for (int i = 0; i < 8; ++i)
#pragma unroll
            for (int j = 0; j < 4; ++j) acc2[MODE == 2 ? i : 0][j] = 0.f;
    }
    for (int k0 = 0; k0 < K; k0 += 16) {
#pragma unroll
        for (int i = 0; i < 2; ++i) {
            const int id = tid + i * 256, r = id >> 2, c4 = id & 3;
            const float4 v = *(const float4*)(A + (size_t)(m0 + r) * lda + k0 + c4 * 4);
            As[c4 * 4 + 0][r] = v.x; As[c4 * 4 + 1][r] = v.y; As[c4 * 4 + 2][r] = v.z; As[c4 * 4 + 3][r] = v.w;
        }
        {
            const int r = tid >> 4, c4 = tid & 15;
            *(float4*)&Bs[r][c4 * 4] = *(const float4*)(B + (size_t)(k0 + r) * ldb + n0 + c4 * 4);
            if (MODE == 2) *(float4*)&Bs2[MODE == 2 ? r : 0][c4 * 4] = *(const float4*)(B2 + (size_t)(k0 + r) * ldb + n0 + c4 * 4);
        }
        __syncthreads();
#pragma unroll
        for (int k = 0; k < 16; ++k) {
            const float4 a0 = *(const float4*)&As[k][ty * 8], a1 = *(const float4*)&As[k][ty * 8 + 4];
            const float4 b = *(const float4*)&Bs[k][tx * 4];
            const float a[8] = {a0.x, a0.y, a0.z, a0.w, a1.x, a1.y, a1.z, a1.w};
            const float bb[4] = {b.x, b.y, b.z, b.w};
#pragma unroll
            for (int i = 0; i < 8; ++i)
#pragma unroll
                for (int j = 0; j < 4; ++j) acc[i][j] = fmaf(a[i], bb[j], acc[i][j]);
            if (MODE == 2) {
                const float4 b2 = *(const float4*)&Bs2[MODE == 2 ? k : 0][tx * 4];
                const float cc[4] = {b2.x, b2.y, b2.z, b2.w};
#pragma unroll
                for (int i = 0; i < 8; ++i)
#pragma unroll
                    for (int j = 0; j < 4; ++j) acc2[MODE == 2 ? i : 0][j] = fmaf(a[i], cc[j], acc2[MODE == 2 ? i : 0][j]);
            }
        }
        __syncthreads();
    }
#pragma unroll
    for (int i = 0; i < 8; ++i) {
        const int row = m0 + ty * 8 + i, col = n0 + tx * 4;
        float o[4];
#pragma unroll
        for (int j = 0; j < 4; ++j) {
            float v = acc[i][j];
            if (MODE == 1) v = R[(size_t)row * ldr + col + j] + alpha * v;
            if (MODE == 2) { const float gt = v; v = gt / (1.f + expf(-gt)) * acc2[MODE == 2 ? i : 0][j]; }
            if (MODE == 3) { const float t = v + bias[col + j]; v = R[(size_t)row * ldr + col + j] / (1.f + expf(-t)); }
            o[j] = v;
        }
        *(float4*)(C + (size_t)row * ldc + col) = make_float4(o[0], o[1], o[2], o[3]);
    }
}

__global__ void __launch_bounds__(64) s5_k(const float* Z, const float* log_step, const float* a_re, const float* a_im, const float* b_re, const float* b_im,
                                           const float* c_re, const float* c_im, const float* dsk, float* Y) {
    __shared__ float Cr[16][65], Ci[16][65], Us[16][16], Sr[16][65], Si[16][65];
    const int g = blockIdx.x, n = threadIdx.x;
    const float dt = expf(log_step[g]);
    const float ar = a_re[g * NS + n], ai = a_im[g * NS + n];
    const float mag = expf(ar * dt), ang = ai * dt;
    const float lr = mag * cosf(ang), li = mag * sinf(ang);
    const float den = ar * ar + ai * ai;
    const float fr = ((lr - 1.f) * ar + li * ai) / den, fi = (li * ar - (lr - 1.f) * ai) / den;
    float Br[16], Bi[16];
#pragma unroll
    for (int c = 0; c < 16; ++c) {
        const float br = b_re[(g * NS + n) * GC + c], bi = b_im[(g * NS + n) * GC + c];
        Br[c] = fr * br - fi * bi; Bi[c] = fr * bi + fi * br;
    }
    for (int c = 0; c < 16; ++c) { Cr[c][n] = c_re[(g * GC + c) * NS + n]; Ci[c][n] = c_im[(g * GC + c) * NS + n]; }
    float sr = 0.f, si = 0.f;
    __syncthreads();
    for (int t0 = 0; t0 < SEQ; t0 += 16) {
#pragma unroll
        for (int j = 0; j < 4; ++j) { const int idx = n + 64 * j, tt = idx >> 4, c = idx & 15; Us[tt][c] = Z[(size_t)(t0 + tt) * DIN + g * GC + c]; }
        __syncthreads();
#pragma unroll
        for (int tt = 0; tt < 16; ++tt) {
            float bur = 0.f, bui = 0.f;
#pragma unroll
            for (int c = 0; c < 16; ++c) { const float u = Us[tt][c]; bur = fmaf(Br[c], u, bur); bui = fmaf(Bi[c], u, bui); }
            const float nsr = lr * sr - li * si + bur, nsi = lr * si + li * sr + bui;
            sr = nsr; si = nsi;
            Sr[tt][n] = sr; Si[tt][n] = si;
        }
        __syncthreads();
#pragma unroll
        for (int j = 0; j < 4; ++j) {
            const int idx = n + 64 * j, tt = idx >> 4, c = idx & 15;
            float y = 0.f;
            for (int m = 0; m < 64; ++m) y += Cr[c][m] * Sr[tt][m] - Ci[c][m] * Si[tt][m];
            y += dsk[g * GC + c] * Us[tt][c];
            const float inner = 0.7978845608028654f * (y + 0.044715f * y * y * y);
            y = 0.5f * y * (1.f + tanhf(inner));
            Y[(size_t)(t0 + tt) * SSMW + g * GC + c] = y;
        }
        __syncthreads();
    }
}

__global__ void __launch_bounds__(64) mla_prep_k(const float* Q, const float* KV, const float* Z, const int* pos, const float* gq, const float* gk,
                                                 float* Qh, float* Kh, float* Vh) {
    const int t = blockIdx.x, h = blockIdx.y, lane = threadIdx.x;
    const int i = lane & 31;
    const float inv_freq = powf(10000.0f, -(float)(2 * i) / 64.0f);
    const float ang = (float)pos[t] * inv_freq;
    const float cs = cosf(ang), sn = sinf(ang);
    {
        float v0 = Q[(size_t)t * 1536 + h * QKH + lane], v1 = Q[(size_t)t * 1536 + h * QKH + 64 + lane], v2 = Q[(size_t)t * 1536 + h * QKH + 128 + lane];
        float ss = v0 * v0 + v1 * v1 + v2 * v2;
        for (int o = 32; o > 0; o >>= 1) ss += __shfl_xor(ss, o);
        const float rs = rsqrtf(ss / 192.f + EPS);
        v0 *= rs * gq[lane]; v1 *= rs * gq[64 + lane]; v2 *= rs * gq[128 + lane];
        const float pr = __shfl_xor(v2, 32);
        const float r = (lane < 32) ? (v2 * cs - pr * sn) : (v2 * cs + pr * sn);
        float* o = Qh + ((size_t)h * SEQ + t) * QKH;
        o[lane] = v0; o[64 + lane] = v1; o[128 + lane] = r;
    }
    {
        float v0 = KV[(size_t)t * 2048 + h * 256 + lane], v1 = KV[(size_t)t * 2048 + h * 256 + 64 + lane], v2 = Z[(size_t)t * DIN + 1792 + lane];
        float ss = v0 * v0 + v1 * v1 + v2 * v2;
        for (int o = 32; o > 0; o >>= 1) ss += __shfl_xor(ss, o);
        const float rs = rsqrtf(ss / 192.f + EPS);
        v0 *= rs * gk[lane]; v1 *= rs * gk[64 + lane]; v2 *= rs * gk[128 + lane];
        const float pr = __shfl_xor(v2, 32);
        const float r = (lane < 32) ? (v2 * cs - pr * sn) : (v2 * cs + pr * sn);
        float* o = Kh + ((size_t)h * SEQ + t) * QKH;
        o[lane] = v0; o[64 + lane] = v1; o[128 + lane] = r;
        float* vo = Vh + ((size_t)h * SEQ + t) * VH;
        vo[lane] = KV[(size_t)t * 2048 + h * 256 + 128 + lane]; vo[64 + lane] = KV[(size_t)t * 2048 + h * 256 + 192 + lane];
    }
}

__global__ void __launch_bounds__(128) attn_k(const float* Qh, const float* Kh, const float* Vh, float* Att) {
    extern __shared__ float sm[];
    float* Qs = sm;
    float* Ks = Qs + 64 * 193;
    float* Vs = Ks + 32 * 192;
    const int c = blockIdx.x, h = blockIdx.y, tid = threadIdx.x, r = tid & 63, half = tid >> 6;
    const float* qp = Qh + ((size_t)h * SEQ + c * 64) * QKH;
    for (int i = tid; i < 64 * 192; i += 128) Qs[(i / 192) * 193 + (i % 192)] = qp[i];
    float o[64];
#pragma unroll
    for (int d = 0; d < 64; ++d) o[d] = 0.f;
    float m = -INFINITY, l = 0.f;
    const float scale = 0.07216878364870322f;
    const int nkt = (c + 1) * 2;
    for (int kt = 0; kt < nkt; ++kt) {
        __syncthreads();
        const float* kp = Kh + ((size_t)h * SEQ + kt * 32) * QKH;
        for (int i = tid; i < 32 * 192; i += 128) Ks[i] = kp[i];
        const float* vp = Vh + ((size_t)h * SEQ + kt * 32) * VH;
        for (int i = tid; i < 32 * 128; i += 128) Vs[i] = vp[i];
        __syncthreads();
        for (int j = 0; j < 32; ++j) {
            float s = 0.f;
#pragma unroll 8
            for (int d = 0; d < 192; ++d) s = fmaf(Qs[r * 193 + d], Ks[j * 192 + d], s);
            s *= scale;
            const float mn = fmaxf(m, s);
            const float f = expf(m - mn), p = expf(s - mn);
            l = l * f + p; m = mn;
#pragma unroll
            for (int d = 0; d < 64; ++d) o[d] = o[d] * f + p * Vs[j * 128 + half * 64 + d];
        }
    }
    const float il = 1.f / l;
    float* op = Att + (size_t)(c * 64 + r) * ATTW + h * VH + half * 64;
#pragma unroll
    for (int d = 0; d < 64; ++d) op[d] = o[d] * il;
}
}

extern "C" void kernel_launch(void* const* d_in, const int* in_sizes, int n_in, void* d_out, int out_size, void* d_ws, size_t ws_size, hipStream_t stream) {
    using namespace nv;
    const float* x = (const float*)d_in[0]; const int* pos = (const int*)d_in[1];
    auto F = [&](int i) { return (const float*)d_in[i]; };
    float* out = (float*)d_out;
    float* ws = (float*)d_ws;
    const int R = SEQ;
    size_t off = 0;
    auto take = [&](size_t n) { float* p = ws + off; off += n; return p; };
    float* XN = take((size_t)R * DM);
    float* H = take((size_t)R * DFF);
    float* X1 = take((size_t)R * DM);
    float* Z = take((size_t)R * DIN);
    float* YR = take((size_t)R * SSMW);
    float* YG = take((size_t)R * SSMW);
    float* Y = take((size_t)R * DM);
    float* QN = take((size_t)R * QL);
    float* KVN = take((size_t)R * KVL);
    float* Q = take((size_t)R * 1536);
    float* KV = take((size_t)R * 2048);
    float* Qh = take((size_t)NH * R * QKH);
    float* Kh = take((size_t)NH * R * QKH);
    float* Vh = take((size_t)NH * R * VH);
    float* ATT = take((size_t)R * ATTW);
    float* X2 = take((size_t)R * DM);
    float* X3 = take((size_t)R * DM);
    const int attn_lds = (64 * 193 + 32 * 192 + 32 * 128) * 4;
    static bool attr_done = false;
    if (!attr_done) { (void)hipFuncSetAttribute((const void*)attn_k, hipFuncAttributeMaxDynamicSharedMemorySize, attn_lds); attr_done = true; }
    for (int b = 0; b < NB; ++b) {
        const float* xb = x + (size_t)b * R * DM;
        float* ob = out + (size_t)b * R * DM;
        const int* pb = pos + b * R;
        rmsnorm_k<<<R, 256, 0, stream>>>(xb, DM, F(2), XN, DM, DM);
        gemm_k<2><<<dim3(DFF / 64, R / 128), 256, 0, stream>>>(XN, DM, F(3), F(4), DFF, H, DFF, DM, nullptr, 0, 0.f, nullptr);
        gemm_k<1><<<dim3(DM / 64, R / 128), 256, 0, stream>>>(H, DFF, F(5), nullptr, DM, X1, DM, DFF, xb, DM, 0.5f, nullptr);
        rmsnorm_k<<<R, 256, 0, stream>>>(X1, DM, F(6), XN, DM, DM);
        gemm_k<0><<<dim3(DIN / 64, R / 128), 256, 0, stream>>>(XN, DM, F(7), nullptr, DIN, Z, DIN, DM, nullptr, 0, 0.f, nullptr);
        s5_k<<<NG, 64, 0, stream>>>(Z, F(8), F(9), F(10), F(11), F(12), F(13), F(14), F(15), YR);
        gemm_k<3><<<dim3(SSMW / 64, R / 128), 256, 0, stream>>>(YR, SSMW, F(16), nullptr, SSMW, YG, SSMW, SSMW, YR, SSMW, 0.f, F(17));
        rmsnorm_k<<<R, 256, 0, stream>>>(YG, SSMW, F(24), Y, DM, SSMW);
        rmsnorm_k<<<R, 256, 0, stream>>>(Z + 1024, DIN, F(18), QN, QL, QL);
        rmsnorm_k<<<R, 256, 0, stream>>>(Z + 1536, DIN, F(20), KVN, KVL, KVL);
        gemm_k<0><<<dim3(1536 / 64, R / 128), 256, 0, stream>>>(QN, QL, F(19), nullptr, 1536, Q, 1536, QL, nullptr, 0, 0.f, nullptr);
        gemm_k<0><<<dim3(2048 / 64, R / 128), 256, 0, stream>>>(KVN, KVL, F(21), nullptr, 2048, KV, 2048, KVL, nullptr, 0, 0.f, nullptr);
        mla_prep_k<<<dim3(R, NH), 64, 0, stream>>>(Q, KV, Z, pb, F(22), F(23), Qh, Kh, Vh);
        attn_k<<<dim3(R / 64, NH), 128, attn_lds, stream>>>(Qh, Kh, Vh, ATT);
        rmsnorm_k<<<R, 256, 0, stream>>>(ATT, ATTW, F(25), Y + 1024, DM, ATTW);
        gemm_k<1><<<dim3(DM / 64, R / 128), 256, 0, stream>>>(Y, DM, F(26), nullptr, DM, X2, DM, DM, X1, DM, 1.0f, nullptr);
        rmsnorm_k<<<R, 256, 0, stream>>>(X2, DM, F(27), XN, DM, DM);
        gemm_k<2><<<dim3(DFF / 64, R / 128), 256, 0, stream>>>(XN, DM, F(28), F(29), DFF, H, DFF, DM, nullptr, 0, 0.f, nullptr);
        gemm_k<1><<<dim3(DM / 64, R / 128), 256, 0, stream>>>(H, DFF, F(30), nullptr, DM, X3, DM, DFF, X2, DM, 0.5f, nullptr);
        rmsnorm_k<<<R, 256, 0, stream>>>(X3, DM, F(31), ob, DM, DM);
    }
}
```

```cpp
#include <hip/hip_runtime.h>
#include <cstdio>
#include <cstdint>
#include <math.h>
namespace pg8 {
#define PG8_LAS __attribute__((address_space(3)))
typedef unsigned short bf16_t;
typedef short bf16x8 __attribute__((ext_vector_type(8)));
typedef float f32x4 __attribute__((ext_vector_type(4)));
typedef unsigned u32x4 __attribute__((ext_vector_type(4)));
constexpr int BM = 256, BK = 64, HALF = 128, HTB = HALF * BK * 2  , STAGE_BYTES = 8 * HTB, NXCD = 8, WGM = 8;

__host__ __device__ __forceinline__ int lds_byte(int r, int c) { const int st = (r >> 4) * 2 + (c >> 5), rr = r & 15, cc = c & 31, ob = rr * 64 + cc * 2; return st * 1024 + (ob ^ (((ob >> 9) & 1) << 5)); }
__host__ __device__ __forceinline__ void stage_rc(int b, int& R, int& C) { const int st = b / 1024, sb = b % 1024, swz = sb ^ (((sb >> 9) & 1) << 5); R = (st >> 1) * 16 + swz / 64; C = (st & 1) * 32 + (swz % 64) / 2; }
__host__ __device__ __forceinline__ int perm32(int rho) { const int n = rho >> 4, i = rho & 15; return 8 * (i >> 2) + 4 * n + (i & 3); }

struct Unit { int pm, pn; };
struct Gemm { const bf16_t* A; const bf16_t* Bt; int M, N, K; };

struct StaticOrder {
    int nM, nN, nwg, G, c;
    __host__ __device__ void init(int M, int N, int G_, int c_) { nM = M / BM; nN = N / BM; nwg = nM * nN; G = G_; c = c_; }
    __host__ __device__ bool next(int i, Unit& u) const {
        const long L = (long)i * G + c; if (L >= nwg) return false;
        int wgid = (int)L; { const int q = nwg / NXCD, r = nwg % NXCD, xcd = wgid % NXCD, off = wgid / NXCD; wgid = (xcd < r ? xcd * (q + 1) : r * (q + 1) + (xcd - r) * q) + off; }
        const int nig = WGM * nN, gid = wgid / nig, fm = gid * WGM, gsz = (nM - fm) < WGM ? (nM - fm) : WGM;
        u.pm = fm + ((wgid % nig) % gsz); u.pn = (wgid % nig) / gsz; return true;
    }
    __device__ __forceinline__ void a_ready(const Unit&) const {}
    __device__ __forceinline__ void done(const Unit&) const {}
};

__device__ __forceinline__ unsigned cvt_pk_bf16(float lo, float hi) { unsigned r; asm volatile("v_cvt_pk_bf16_f32 %0, %1, %2" : "=v"(r) : "v"(lo), "v"(hi)); return r; }
constexpr float RMS_EPS = 1e-6f;
__device__ __forceinline__ float rstd_of(float ss, float inv_dim) { return rsqrtf(ss * inv_dim + RMS_EPS); }
__device__ __forceinline__ float fq_sum(float v) { v += __shfl_xor(v, 16); v += __shfl_xor(v, 32); return v; }

struct EpiSwiGLU {
    static constexpr bool PERM = true, AFTER_DRAIN = false, HAS_MID = false;
    bf16_t* H; int ldh; const float* SS; float inv_dim;
    __device__ __forceinline__ void operator()(const f32x4 (&acc)[2][2][4][2], const Unit& u, int wr, int wc, int fr, int fq) const {
        const int row0 = u.pm * BM + wr * 64 + fr, col0 = u.pn * HALF + wc * 32 + 8 * fq;
#pragma unroll
        for (int ai = 0; ai < 2; ++ai)
#pragma unroll
            for (int m = 0; m < 4; ++m) {
                const int row = row0 + ai * HALF + m * 16;
                const float rs = rstd_of(SS[row], inv_dim);
                float h[8];
#pragma unroll
                for (int n = 0; n < 2; ++n)
#pragma unroll
                    for (int j = 0; j < 4; ++j) {
                        const float g = acc[ai][0][m][n][j] * rs, up = acc[ai][1][m][n][j] * rs;
                        const float e = __builtin_amdgcn_exp2f(-1.4426950408889634f * g);
                        h[n * 4 + j] = g * __builtin_amdgcn_rcpf(1.0f + e) * up;
                    }
                u32x4 w; w.x = cvt_pk_bf16(h[0], h[1]); w.y = cvt_pk_bf16(h[2], h[3]); w.z = cvt_pk_bf16(h[4], h[5]); w.w = cvt_pk_bf16(h[6], h[7]);
                *(u32x4*)(H + (size_t)row * ldh + col0) = w;
            }
    }
};

struct EpiResid {
    static constexpr bool PERM = true, AFTER_DRAIN = false, HAS_MID = false;
    const float* base; float* out; bf16_t* xb; float* SSo; float alpha; int ld;
    __device__ __forceinline__ void operator()(const f32x4 (&acc)[2][2][4][2], const Unit& u, int wr, int wc, int fr, int fq) const {
        const int row0 = u.pm * BM + wr * 64 + fr, col0 = u.pn * BM + wc * 32 + 8 * fq;
#pragma unroll
        for (int ai = 0; ai < 2; ++ai)
#pragma unroll
            for (int m = 0; m < 4; ++m) {
                const int row = row0 + ai * HALF + m * 16;
                float ssq = 0.f;
#pragma unroll
                for (int bj = 0; bj < 2; ++bj) {
                    const size_t off = (size_t)row * ld + col0 + bj * HALF;
                    const f32x4 b0 = *(const f32x4*)(base + off), b1 = *(const f32x4*)(base + off + 4);
                    const f32x4 v0 = b0 + acc[ai][bj][m][0] * alpha, v1 = b1 + acc[ai][bj][m][1] * alpha;
                    *(f32x4*)(out + off) = v0; *(f32x4*)(out + off + 4) = v1;
                    ssq += (v0[0] * v0[0] + v0[1] * v0[1]) + (v0[2] * v0[2] + v0[3] * v0[3]) + (v1[0] * v1[0] + v1[1] * v1[1]) + (v1[2] * v1[2] + v1[3] * v1[3]);
                    if (xb) { u32x4 w; w.x = cvt_pk_bf16(v0[0], v0[1]); w.y = cvt_pk_bf16(v0[2], v0[3]); w.z = cvt_pk_bf16(v1[0], v1[1]); w.w = cvt_pk_bf16(v1[2], v1[3]);
                        *(u32x4*)(xb + off) = w; }
                }
                ssq = fq_sum(ssq);
                if (fq == 0) atomicAdd(SSo + row, ssq);
            }
    }
};

struct EpiWin {
    static constexpr bool PERM = true, AFTER_DRAIN = false, HAS_MID = false;
    const float* SSin; bf16_t* U; bf16_t* QLAT; bf16_t* KVLAT; float* KPE; float* SSQo; float* SSKVo;
    __device__ __forceinline__ void operator()(const f32x4 (&acc)[2][2][4][2], const Unit& u, int wr, int wc, int fr, int fq) const {
        const int row0 = u.pm * BM + wr * 64 + fr, cl = wc * 32 + 8 * fq, pn = u.pn;
#pragma unroll
        for (int ai = 0; ai < 2; ++ai)
#pragma unroll
            for (int m = 0; m < 4; ++m) {
                const int row = row0 + ai * HALF + m * 16;
                const float rs = rstd_of(SSin[row], 1.0f / 2048.0f);
                float ssq = 0.f;
#pragma unroll
                for (int bj = 0; bj < 2; ++bj) {
                    const int tc = bj * HALF + cl;
                    const f32x4 v0 = acc[ai][bj][m][0] * rs, v1 = acc[ai][bj][m][1] * rs;
                    u32x4 w; w.x = cvt_pk_bf16(v0[0], v0[1]); w.y = cvt_pk_bf16(v0[2], v0[3]); w.z = cvt_pk_bf16(v1[0], v1[1]); w.w = cvt_pk_bf16(v1[2], v1[3]);
                    ssq += (v0[0] * v0[0] + v0[1] * v0[1]) + (v0[2] * v0[2] + v0[3] * v0[3]) + (v1[0] * v1[0] + v1[1] * v1[1]) + (v1[2] * v1[2] + v1[3] * v1[3]);
                    if (pn < 4) *(u32x4*)(U + (size_t)row * 1024 + pn * 256 + tc) = w;
                    else if (pn < 6) *(u32x4*)(QLAT + (size_t)row * 512 + (pn - 4) * 256 + tc) = w;
                    else if (pn == 6) *(u32x4*)(KVLAT + (size_t)row * 256 + tc) = w;
                    else if (tc < 64) { *(f32x4*)(KPE + (size_t)row * 64 + tc) = v0; *(f32x4*)(KPE + (size_t)row * 64 + tc + 4) = v1; }
                }
                if (pn >= 4 && pn < 7) { ssq = fq_sum(ssq); if (fq == 0) atomicAdd((pn < 6 ? SSQo : SSKVo) + row, ssq); }
            }
    }
};

#define PG8_EPI_BAR() do { asm volatile("s_waitcnt lgkmcnt(0)" ::: "memory"); __builtin_amdgcn_s_barrier(); asm volatile("" ::: "memory"); } while (0)
struct EpiQ {
    static constexpr bool PERM = true, AFTER_DRAIN = true, HAS_MID = false;
    const float* SSQ; const float* gq; const float* CS; const float* SN; bf16_t* QH; float qscale;
    __device__ __forceinline__ void fused(f32x4 (&acc)[2][2][4][2], const Unit& u, int wr, int wc, int fr, int fq, PG8_LAS unsigned char* lds, int wid, int lane) const {
        PG8_LAS float* P = (PG8_LAS float*)lds;
        const int h = u.pn;
#pragma unroll
        for (int ai = 0; ai < 2; ++ai)
#pragma unroll
            for (int m = 0; m < 4; ++m) {
                const int rt = ai * HALF + wr * 64 + m * 16 + fr, grow = u.pm * BM + rt;
                const float rs = rstd_of(SSQ[grow], 1.0f / 512.0f);
                float s = 0.f;
#pragma unroll
                for (int bj = 0; bj < 2; ++bj)
#pragma unroll
                    for (int n = 0; n < 2; ++n) { f32x4 v = acc[ai][bj][m][n] * rs; acc[ai][bj][m][n] = v; s += (v[0] * v[0] + v[1] * v[1]) + (v[2] * v[2] + v[3] * v[3]); }
                s = fq_sum(s);
                if (fq == 0) P[rt * 4 + wc] = s;
            }
        PG8_EPI_BAR();
#pragma unroll
        for (int ai = 0; ai < 2; ++ai)
#pragma unroll
            for (int m = 0; m < 4; ++m) {
                const int rt = ai * HALF + wr * 64 + m * 16 + fr, grow = u.pm * BM + rt;
                const f32x4 pp = *(const PG8_LAS f32x4*)(P + rt * 4);
                const float r192 = rsqrtf(((pp[0] + pp[1]) + (pp[2] + pp[3])) * (1.0f / 192.0f) + RMS_EPS) * qscale;
                bf16_t* dst = QH + ((size_t)((grow >> 11) * 8 + h) * 2048 + (grow & 2047)) * 192;
                {
                    const int c = wc * 32 + 8 * fq;
                    const f32x4 g0 = *(const f32x4*)(gq + c), g1 = *(const f32x4*)(gq + c + 4);
                    const f32x4 v0 = acc[ai][0][m][0] * g0 * r192, v1 = acc[ai][0][m][1] * g1 * r192;
                    u32x4 w; w.x = cvt_pk_bf16(v0[0], v0[1]); w.y = cvt_pk_bf16(v0[2], v0[3]); w.z = cvt_pk_bf16(v1[0], v1[1]); w.w = cvt_pk_bf16(v1[2], v1[3]);
                    *(u32x4*)(dst + c) = w;
                }
                if (wc < 2) {
                    const int i0 = 16 * wc + 4 * fq;
                    const f32x4 cs = *(const f32x4*)(CS + (size_t)grow * 32 + i0), sn = *(const f32x4*)(SN + (size_t)grow * 32 + i0);
                    const f32x4 ga = *(const f32x4*)(gq + 128 + i0), gb = *(const f32x4*)(gq + 160 + i0);
                    float o[8];
#pragma unroll
                    for (int p = 0; p < 4; ++p) {
                        const float x1 = acc[ai][1][m][p >> 1][2 * (p & 1)] * ga[p] * r192, x2 = acc[ai][1][m][p >> 1][2 * (p & 1) + 1] * gb[p] * r192;
                        o[2 * p] = x1 * cs[p] - x2 * sn[p]; o[2 * p + 1] = x2 * cs[p] + x1 * sn[p];
                    }
                    u32x4 w; w.x = cvt_pk_bf16(o[0], o[1]); w.y = cvt_pk_bf16(o[2], o[3]); w.z = cvt_pk_bf16(o[4], o[5]); w.w = cvt_pk_bf16(o[6], o[7]);
                    *(u32x4*)(dst + 128 + 2 * i0) = w;
                }
            }
        PG8_EPI_BAR();
    }
};
struct EpiKV {
    static constexpr bool PERM = true, AFTER_DRAIN = true, HAS_MID = false;
    const float* SSKV; const float* gk; const float* KPE; const float* CS; const float* SN; bf16_t* KH; bf16_t* VH;
    __device__ __forceinline__ void fused(f32x4 (&acc)[2][2][4][2], const Unit& u, int wr, int wc, int fr, int fq, PG8_LAS unsigned char* lds, int wid, int lane) const {
        PG8_LAS float* P = (PG8_LAS float*)lds;
        const int h = u.pn, e0 = 4 * (4 * wc + fq);
#pragma unroll
        for (int ai = 0; ai < 2; ++ai)
#pragma unroll
            for (int m = 0; m < 4; ++m) {
                const int rt = ai * HALF + wr * 64 + m * 16 + fr, grow = u.pm * BM + rt;
                const float rs = rstd_of(SSKV[grow], 1.0f / 256.0f);
                const f32x4 kp = *(const f32x4*)(KPE + (size_t)grow * 64 + e0);
                float s = (kp[0] * kp[0] + kp[1] * kp[1]) + (kp[2] * kp[2] + kp[3] * kp[3]);
#pragma unroll
                for (int bj = 0; bj < 2; ++bj)
#pragma unroll
                    for (int n = 0; n < 2; ++n) { f32x4 v = acc[ai][bj][m][n] * rs; acc[ai][bj][m][n] = v; if (bj == 0) s += (v[0] * v[0] + v[1] * v[1]) + (v[2] * v[2] + v[3] * v[3]); }
                s = fq_sum(s);
                if (fq == 0) P[rt * 4 + wc] = s;
            }
        PG8_EPI_BAR();
#pragma unroll
        for (int ai = 0; ai < 2; ++ai)
#pragma unroll
            for (int m = 0; m < 4; ++m) {
                const int rt = ai * HALF + wr * 64 + m * 16 + fr, grow = u.pm * BM + rt;
                const f32x4 pp = *(const PG8_LAS f32x4*)(P + rt * 4);
                const float rk = rsqrtf(((pp[0] + pp[1]) + (pp[2] + pp[3])) * (1.0f / 192.0f) + RMS_EPS);
                const size_t bh_t = (size_t)((grow >> 11) * 8 + h) * 2048 + (grow & 2047);
                bf16_t* kd = KH + bh_t * 192; bf16_t* vd = VH + bh_t * 128;
                const int c = wc * 32 + 8 * fq;
                {
                    const f32x4 g0 = *(const f32x4*)(gk + c), g1 = *(const f32x4*)(gk + c + 4);
                    const f32x4 v0 = acc[ai][0][m][0] * g0 * rk, v1 = acc[ai][0][m][1] * g1 * rk;
                    u32x4 w; w.x = cvt_pk_bf16(v0[0], v0[1]); w.y = cvt_pk_bf16(v0[2], v0[3]); w.z = cvt_pk_bf16(v1[0], v1[1]); w.w = cvt_pk_bf16(v1[2], v1[3]);
                    *(u32x4*)(kd + c) = w;
                }
                {
                    const f32x4 v0 = acc[ai][1][m][0], v1 = acc[ai][1][m][1];
                    u32x4 w; w.x = cvt_pk_bf16(v0[0], v0[1]); w.y = cvt_pk_bf16(v0[2], v0[3]); w.z = cvt_pk_bf16(v1[0], v1[1]); w.w = cvt_pk_bf16(v1[2], v1[3]);
                    *(u32x4*)(vd + c) = w;
                }
                {
                    const int i0 = e0 >> 1;
                    const f32x4 kp = *(const f32x4*)(KPE + (size_t)grow * 64 + e0);
                    const float c0 = CS[(size_t)grow * 32 + i0], c1 = CS[(size_t)grow * 32 + i0 + 1], s0 = SN[(size_t)grow * 32 + i0], s1 = SN[(size_t)grow * 32 + i0 + 1];
                    const float a0 = kp[0] * gk[128 + i0] * rk, b0 = kp[1] * gk[160 + i0] * rk, a1 = kp[2] * gk[128 + i0 + 1] * rk, b1 = kp[3] * gk[160 + i0 + 1] * rk;
                    typedef unsigned u32x2 __attribute__((ext_vector_type(2)));
                    u32x2 w; w.x = cvt_pk_bf16(a0 * c0 - b0 * s0, b0 * c0 + a0 * s0); w.y = cvt_pk_bf16(a1 * c1 - b1 * s1, b1 * c1 + a1 * s1);
                    *(u32x2*)(kd + 128 + e0) = w;
                }
            }
        PG8_EPI_BAR();
    }
};
struct EpiGLU {
    static constexpr bool PERM = true, AFTER_DRAIN = false, HAS_MID = false;
    const bf16_t* YSv; const float* bias; bf16_t* Y; int ldy; float* SSo;
    __device__ __forceinline__ void operator()(const f32x4 (&acc)[2][2][4][2], const Unit& u, int wr, int wc, int fr, int fq) const {
        const int row0 = u.pm * BM + wr * 64 + fr, col0 = u.pn * BM + wc * 32 + 8 * fq;
#pragma unroll
        for (int ai = 0; ai < 2; ++ai)
#pragma unroll
            for (int m = 0; m < 4; ++m) {
                const int row = row0 + ai * HALF + m * 16;
                float ssq = 0.f;
#pragma unroll
                for (int bj = 0; bj < 2; ++bj) {
                    const int col = col0 + bj * HALF;
                    const u32x4 yv = *(const u32x4*)(YSv + (size_t)row * 1024 + col);
                    const f32x4 b0 = *(const f32x4*)(bias + col), b1 = *(const f32x4*)(bias + col + 4);
                    float o[8];
#pragma unroll
                    for (int e = 0; e < 8; ++e) {
                        const float t = (e < 4 ? acc[ai][bj][m][0][e & 3] + b0[e & 3] : acc[ai][bj][m][1][e & 3] + b1[e & 3]);
                        const unsigned wv = yv[e >> 1]; const float y = __builtin_bit_cast(float, (e & 1) ? (wv & 0xffff0000u) : (wv << 16));
                        o[e] = y * __builtin_amdgcn_rcpf(1.0f + __builtin_amdgcn_exp2f(-1.4426950408889634f * t));
                        ssq += o[e] * o[e];
                    }
                    u32x4 w; w.x = cvt_pk_bf16(o[0], o[1]); w.y = cvt_pk_bf16(o[2], o[3]); w.z = cvt_pk_bf16(o[4], o[5]); w.w = cvt_pk_bf16(o[6], o[7]);
                    *(u32x4*)(Y + (size_t)row * ldy + col) = w;
                }
                ssq = fq_sum(ssq);
                if (fq == 0) atomicAdd(SSo + row, ssq);
            }
    }
};
struct EpiWout {
    static constexpr bool PERM = true, AFTER_DRAIN = false, HAS_MID = true;
    const float* SSs; const float* SSa; float* RSio; bf16_t* xb; float* SSo; int ld;
    __device__ __forceinline__ void mid(f32x4 (&acc)[2][2][4][2], const Unit& u, int t, int wr, int wc, int fr, int fq) const {
        if (t != 16) return;
        int rz = u.pm * BM + wr * 64 + fr; asm volatile("" : "+v"(rz));
        const unsigned boff = (unsigned)rz * 4u;
#pragma unroll
        for (int ai = 0; ai < 2; ++ai)
#pragma unroll
            for (int m = 0; m < 4; ++m) {
                const unsigned o = boff + (unsigned)(ai * HALF + m * 16) * 4u;
                const float ratio = rstd_of(*(const float*)((const char*)SSs + o), 1.0f / 1024.0f) / rstd_of(*(const float*)((const char*)SSa + o), 1.0f / 1024.0f);
#pragma unroll
                for (int bj = 0; bj < 2; ++bj)
#pragma unroll
                    for (int n = 0; n < 2; ++n) acc[ai][bj][m][n] *= ratio;
            }
    }
    __device__ __forceinline__ void operator()(const f32x4 (&acc)[2][2][4][2], const Unit& u, int wr, int wc, int fr, int fq) const {
        const int row0 = u.pm * BM + wr * 64 + fr, col0 = u.pn * BM + wc * 32 + 8 * fq;
#pragma unroll
        for (int ai = 0; ai < 2; ++ai)
#pragma unroll
            for (int m = 0; m < 4; ++m) {
                const int row = row0 + ai * HALF + m * 16;
                const float ra = rstd_of(SSa[row], 1.0f / 1024.0f);
                float ssq = 0.f;
#pragma unroll
                for (int bj = 0; bj < 2; ++bj) {
                    const size_t off = (size_t)row * ld + col0 + bj * HALF;
                    const f32x4 b0 = *(const f32x4*)(RSio + off), b1 = *(const f32x4*)(RSio + off + 4);
                    const f32x4 v0 = b0 + acc[ai][bj][m][0] * ra, v1 = b1 + acc[ai][bj][m][1] * ra;
                    *(f32x4*)(RSio + off) = v0; *(f32x4*)(RSio + off + 4) = v1;
                    ssq += (v0[0] * v0[0] + v0[1] * v0[1]) + (v0[2] * v0[2] + v0[3] * v0[3]) + (v1[0] * v1[0] + v1[1] * v1[1]) + (v1[2] * v1[2] + v1[3] * v1[3]);
                    u32x4 w; w.x = cvt_pk_bf16(v0[0], v0[1]); w.y = cvt_pk_bf16(v0[2], v0[3]); w.z = cvt_pk_bf16(v1[0], v1[1]); w.w = cvt_pk_bf16(v1[2], v1[3]);
                    *(u32x4*)(xb + off) = w;
                }
                ssq = fq_sum(ssq);
                if (fq == 0) atomicAdd(SSo + row, ssq);
            }
    }
};
template <class Epi, class Sched, bool ALIGN_EPI = false, bool SP2 = false>
__device__ __forceinline__ void gemm_phase(PG8_LAS unsigned char* lds, const Gemm g, const Sched& S, const Epi& E) {
    const int tid = threadIdx.x, wid = __builtin_amdgcn_readfirstlane(tid >> 6), lane = tid & 63, wr = wid >> 2, wc = wid & 3, fr = lane & 15, fq = lane >> 4;
    const int K = g.K, nt = K / BK;
    unsigned voffA[2], voffB[2];
#pragma unroll
    for (int i = 0; i < 2; ++i) { int R, C; stage_rc(tid * 16 + i * 8192, R, C); const int Rb = Epi::PERM ? ((R & ~31) + perm32(R & 31)) : R;
        voffA[i] = (unsigned)(R * K + C) * 2u; voffB[i] = (unsigned)(Rb * K + C) * 2u; }
    const size_t kstep = (size_t)(BK * 2);
    const size_t hstep = (size_t)HALF * K * 2;
    const size_t tstep = 2 * hstep;
    const unsigned ldsw = (unsigned)wid * 1024u;
    const int aoff = lds_byte(wr * 64 + fr, fq * 8), boff = lds_byte(wc * 32 + fr, fq * 8);
#define PG8_SA(b, h) (((b) * 2 + (h)) * HTB)
#define PG8_SB(b, h) ((4 + (b) * 2 + (h)) * HTB)
#define PG8_STAGE(bufoff, gbase, voff) do { _Pragma("unroll") for (int _i = 0; _i < 2; ++_i) \
        __builtin_amdgcn_global_load_lds((const unsigned*)((const char*)(gbase) + (voff)[_i]), (PG8_LAS unsigned*)(lds + (bufoff) + ldsw + _i * 8192), 16, 0, 0); } while (0)
#define PG8_LDA(dst, b, h) do { _Pragma("unroll") for (int m = 0; m < 4; ++m) _Pragma("unroll") for (int k = 0; k < 2; ++k) dst[m][k] = *(const PG8_LAS bf16x8*)(lds + PG8_SA(b, h) + aoff + m * 2048 + k * 1024); } while (0)
#define PG8_LDB(dst, b, h) do { _Pragma("unroll") for (int n = 0; n < 2; ++n) _Pragma("unroll") for (int k = 0; k < 2; ++k) dst[n][k] = *(const PG8_LAS bf16x8*)(lds + PG8_SB(b, h) + boff + n * 2048 + k * 1024); } while (0)
#define PG8_MMA(ai, bj, At, Bt) do { __builtin_amdgcn_s_setprio(1); _Pragma("unroll") for (int m = 0; m < 4; ++m) _Pragma("unroll") for (int n = 0; n < 2; ++n) _Pragma("unroll") for (int k = 0; k < 2; ++k) \
        acc[ai][bj][m][n] = __builtin_amdgcn_mfma_f32_16x16x32_bf16(Bt[n][k], At[m][k], acc[ai][bj][m][n], 0, 0, 0); __builtin_amdgcn_s_setprio(0); } while (0)
#define PG8_WAIT_V(n) asm volatile("s_waitcnt vmcnt(" #n ")" ::: "memory")
#define PG8_WAIT_L(n) asm volatile("s_waitcnt lgkmcnt(" #n ")" ::: "memory")
#define PG8_BAR __builtin_amdgcn_s_barrier()
#define PG8_SCHED __builtin_amdgcn_sched_barrier(0)
    Unit cur, nxt; int ui = 0;
    if (!S.next(0, cur)) return;
    f32x4 acc[2][2][4][2];
#pragma unroll
    for (int a = 0; a < 2; ++a)
#pragma unroll
        for (int b = 0; b < 2; ++b)
#pragma unroll
            for (int m = 0; m < 4; ++m)
#pragma unroll
                for (int n = 0; n < 2; ++n) acc[a][b][m][n] = (f32x4){0.f, 0.f, 0.f, 0.f};
    bf16x8 At[4][2], B0[2][2], B1[2][2];
    const char* cA = (const char*)g.A + (size_t)cur.pm * tstep; const char* cB = (const char*)g.Bt + (size_t)cur.pn * tstep;
    S.a_ready(cur);
    if constexpr (SP2) {
        PG8_STAGE(PG8_SB(0, 0), cB, voffB); PG8_STAGE(PG8_SB(0, 1), cB + hstep, voffB); PG8_STAGE(PG8_SA(0, 0), cA, voffA); PG8_STAGE(PG8_SA(0, 1), cA + hstep, voffA);
        if (wr == 1) PG8_BAR;
        PG8_WAIT_V(2); PG8_BAR;
        PG8_STAGE(PG8_SB(1, 0), cB + kstep, voffB); PG8_STAGE(PG8_SA(1, 0), cA + kstep, voffA); PG8_STAGE(PG8_SB(1, 1), cB + hstep + kstep, voffB);
        PG8_WAIT_V(6); PG8_BAR;
    } else {
        PG8_STAGE(PG8_SB(0, 0), cB, voffB); PG8_STAGE(PG8_SA(0, 0), cA, voffA); PG8_STAGE(PG8_SB(0, 1), cB + hstep, voffB); PG8_STAGE(PG8_SA(0, 1), cA + hstep, voffA);
        if (wr == 1) PG8_BAR;
        PG8_WAIT_V(4); PG8_BAR;
        PG8_STAGE(PG8_SB(1, 0), cB + kstep, voffB); PG8_STAGE(PG8_SA(1, 0), cA + kstep, voffA); PG8_STAGE(PG8_SB(1, 1), cB + hstep + kstep, voffB);
        PG8_WAIT_V(6); PG8_BAR;
    }
    for (;;) {
        const bool has_next = S.next(ui + 1, nxt);
        const char* nA = has_next ? (const char*)g.A + (size_t)nxt.pm * tstep : cA; const char* nB = has_next ? (const char*)g.Bt + (size_t)nxt.pn * tstep : cB;
        for (int t = 0; t < nt; t += 2) {
            if constexpr (Epi::HAS_MID) E.mid(acc, cur, t, wr, wc, fr, fq);
            const bool last = (t == nt - 2);
            const char* a1 = cA + (size_t)(t + 1) * kstep;
            const char* a2 = last ? nA : cA + (size_t)(t + 2) * kstep; const char* b2 = last ? nB : cB + (size_t)(t + 2) * kstep;
            const char* a3 = a2 + kstep; const char* b3 = b2 + kstep;
            if (last && has_next) S.a_ready(nxt);
            if constexpr (SP2) {
            PG8_LDB(B0, 0, 0); PG8_LDB(B1, 0, 1); PG8_SCHED; PG8_LDA(At, 0, 0); PG8_STAGE(PG8_SA(1, 1), a1 + hstep, voffA);
            PG8_WAIT_V(8); PG8_WAIT_L(0); PG8_BAR; PG8_MMA(0, 0, At, B0); PG8_MMA(0, 1, At, B1); PG8_BAR; PG8_SCHED;
            PG8_LDA(At, 0, 1); PG8_STAGE(PG8_SB(0, 0), b2, voffB); PG8_STAGE(PG8_SB(0, 1), b2 + hstep, voffB); PG8_STAGE(PG8_SA(0, 0), a2, voffA);
            PG8_WAIT_V(8); PG8_WAIT_L(0); PG8_BAR; PG8_MMA(1, 0, At, B0); PG8_MMA(1, 1, At, B1); PG8_BAR; PG8_SCHED;
            PG8_LDB(B0, 1, 0); PG8_LDB(B1, 1, 1); PG8_SCHED; PG8_LDA(At, 1, 0); PG8_STAGE(PG8_SA(0, 1), a2 + hstep, voffA);
            PG8_WAIT_V(8); PG8_WAIT_L(0); PG8_BAR; PG8_MMA(0, 0, At, B0); PG8_MMA(0, 1, At, B1); PG8_BAR; PG8_SCHED;
            PG8_LDA(At, 1, 1); PG8_STAGE(PG8_SB(1, 0), b3, voffB); PG8_STAGE(PG8_SB(1, 1), b3 + hstep, voffB); PG8_STAGE(PG8_SA(1, 0), a3, voffA);
            PG8_WAIT_V(8); PG8_WAIT_L(0); PG8_BAR; PG8_MMA(1, 0, At, B0); PG8_MMA(1, 1, At, B1); PG8_BAR; PG8_SCHED;
            } else {
            PG8_LDB(B0, 0, 0); PG8_SCHED; PG8_LDA(At, 0, 0); PG8_STAGE(PG8_SA(1, 1), a1 + hstep, voffA);
            PG8_WAIT_L(8); PG8_BAR; PG8_WAIT_L(0); PG8_MMA(0, 0, At, B0); PG8_BAR; PG8_SCHED;
            PG8_LDB(B1, 0, 1); PG8_STAGE(PG8_SB(0, 0), b2, voffB);
            PG8_BAR; PG8_WAIT_L(0); PG8_MMA(0, 1, At, B1); PG8_BAR;
            PG8_LDA(At, 0, 1); PG8_STAGE(PG8_SA(0, 0), a2, voffA);
            PG8_BAR; PG8_WAIT_L(0); PG8_MMA(1, 0, At, B0); PG8_BAR; PG8_SCHED;
            PG8_STAGE(PG8_SB(0, 1), b2 + hstep, voffB);
            PG8_WAIT_V(6); PG8_BAR; PG8_MMA(1, 1, At, B1); PG8_BAR;
            PG8_LDB(B0, 1, 0); PG8_SCHED; PG8_LDA(At, 1, 0); PG8_STAGE(PG8_SA(0, 1), a2 + hstep, voffA);
            PG8_WAIT_L(8); PG8_BAR; PG8_WAIT_L(0); PG8_MMA(0, 0, At, B0); PG8_BAR; PG8_SCHED;
            PG8_LDB(B1, 1, 1); PG8_STAGE(PG8_SB(1, 0), b3, voffB);
            PG8_BAR; PG8_WAIT_L(0); PG8_MMA(0, 1, At, B1); PG8_BAR;
            PG8_LDA(At, 1, 1); PG8_STAGE(PG8_SA(1, 0), a3, voffA);
            PG8_BAR; PG8_WAIT_L(0); PG8_MMA(1, 0, At, B0); PG8_BAR; PG8_SCHED;
            PG8_STAGE(PG8_SB(1, 1), b3 + hstep, voffB);
            PG8_WAIT_V(6); PG8_BAR; PG8_MMA(1, 1, At, B1); PG8_BAR;
            }
        }
        if constexpr (ALIGN_EPI) { if (wr == 0) PG8_BAR; }
        if constexpr (!Epi::AFTER_DRAIN) { E(acc, cur, wr, wc, fr, fq); S.done(cur); }
        if (!has_next) break;
#pragma unroll
        for (int a = 0; a < 2; ++a)
#pragma unroll
            for (int b = 0; b < 2; ++b)
#pragma unroll
                for (int m = 0; m < 4; ++m)
#pragma unroll
                    for (int n = 0; n < 2; ++n) acc[a][b][m][n] = (f32x4){0.f, 0.f, 0.f, 0.f};
        cur = nxt; cA = nA; cB = nB; ++ui;
        if constexpr (ALIGN_EPI) { if (wr == 1) PG8_BAR; }
    }
    PG8_WAIT_V(0);
    if constexpr (!ALIGN_EPI) { if (wr == 0) PG8_BAR; }
    PG8_BAR;
    if constexpr (Epi::AFTER_DRAIN) { E.fused(acc, cur, wr, wc, fr, fq, lds, wid, lane); S.done(cur); }
#undef PG8_SA
#undef PG8_SB
#undef PG8_STAGE
#undef PG8_LDA
#undef PG8_LDB
#undef PG8_MMA
#undef PG8_WAIT_V
#undef PG8_WAIT_L
#undef PG8_BAR
#undef PG8_SCHED
}
}

constexpr int NWAVES = 8;
constexpr int DM = 2048, NB = 4, SEQ = 2048, MT = NB * SEQ  , DFF = 5632, DIN = 1856, DINP = 2048  , SSMW = 1024, NG = 64, NS = 64, GC = 16;
constexpr int NH = 8, QKH = 192, VHD = 128, ATTW = 1024, QL = 512, KVL = 256, QUPP = NH * 256  , KVUP = NH * 256;
constexpr float EPS = 1e-6f;
constexpr float QSCALE = 0.07216878364870322f * 1.4426950408889634f;
constexpr size_t MiB = 1u << 20;
constexpr size_t WS_CTL = 0, CTL_ZERO_BYTES = 64 * 1024 + 8 * 32768;
constexpr size_t WS_SS = 64 * 1024;
constexpr size_t WS_CS = 2 * MiB, WS_SN = 3 * MiB;
constexpr size_t WS_KPE = 4 * MiB;
constexpr size_t WS_TAB = 6 * MiB;
constexpr size_t WS_KT = 8 * MiB, WS_PF = 10 * MiB, WS_RF = 26 * MiB;
constexpr size_t WS_W1GU = 42 * MiB, WS_W1D = 86 * MiB, WS_W2GU = 108 * MiB, WS_W2D = 152 * MiB;
constexpr size_t WS_WIN = 174 * MiB, WS_WOUT = 182 * MiB, WS_WGLU = 190 * MiB, WS_WQ = 192 * MiB, WS_WKV = 194 * MiB;
constexpr size_t WS_XB = 196 * MiB;
constexpr size_t WS_H = 228 * MiB;
constexpr size_t WS_END = 316 * MiB;
constexpr size_t WS_QH = WS_W1GU, WS_KH = WS_W1GU + 24 * MiB, WS_VH = WS_W1GU + 48 * MiB;
constexpr size_t WS_Y = WS_H;
constexpr size_t WS_U = WS_H, WS_QLAT = WS_H + 16 * MiB, WS_KVLAT = WS_H + 24 * MiB;
constexpr size_t WS_YS = WS_H + 32 * MiB;
enum { SS1 = 0, SS2, SSQ, SSKV, SSS, SSA, SS3, SS4, NSS };
constexpr int CW_BAR = 1024;
constexpr int RING_OFF = 0, RING_BYTES = 131072;
constexpr int LDSCTL_OFF = RING_BYTES, MISC_OFF = LDSCTL_OFF + 320;
constexpr int LDS_BYTES = 147456;

#define GAS __attribute__((address_space(1)))
#define LAS __attribute__((address_space(3)))
typedef unsigned short bf16;
typedef unsigned v4u __attribute__((ext_vector_type(4)));
typedef unsigned v2u __attribute__((ext_vector_type(2)));
typedef float f32x4 __attribute__((ext_vector_type(4)));
typedef float f32x16 __attribute__((ext_vector_type(16)));
typedef short bf16x8 __attribute__((ext_vector_type(8)));
typedef GAS unsigned gu32;
#define RLX_AGENT __ATOMIC_RELAXED, __HIP_MEMORY_SCOPE_AGENT
#define LDS_WAIT() asm volatile("s_waitcnt lgkmcnt(0)" ::: "memory")
#define VM_WAIT() asm volatile("s_waitcnt vmcnt(0)" ::: "memory")
__device__ __forceinline__ unsigned f2bf(float f) { unsigned u = __builtin_bit_cast(unsigned, f); return (u + 0x7fffu + ((u >> 16) & 1u)) >> 16; }
__device__ __forceinline__ unsigned pk2(float lo, float hi) { return f2bf(lo) | (f2bf(hi) << 16); }
__device__ __forceinline__ float bf2f(unsigned short b) { return __builtin_bit_cast(float, (unsigned)b << 16); }
__device__ __forceinline__ float wave_sum(float v) {
#pragma unroll
    for (int o = 1; o < 64; o <<= 1) v += __shfl_xor(v, o);
    return v;
}
#define XB_TMO      128
#define XB_XCNT(j)  (256  + 64 * (j))
#define XB_XSUB(j)  (1280 + 64 * (j))
#define XB_XGEN(j)  (2304 + 64 * (j))
#define XB_TOP      3328
#define XB_TOPGEN   3392
#define XCD_BAR_WORDS 3456
#define XB_SPIN_CAP (1u << 18)

__device__ __forceinline__ unsigned xb_ld(unsigned* p)              { return __hip_atomic_load(p, __ATOMIC_RELAXED, __HIP_MEMORY_SCOPE_AGENT); }
__device__ __forceinline__ unsigned xb_add(unsigned* p, unsigned v) { return __hip_atomic_fetch_add(p, v, __ATOMIC_RELAXED, __HIP_MEMORY_SCOPE_AGENT); }
__device__ __forceinline__ unsigned xb_xcc_id() { return (unsigned)__builtin_amdgcn_s_getreg((3 << 11) | 20) & 0xFu; }
#define XB_SPIN(cond, bar) do { unsigned _sp = 0; while (cond) { __builtin_amdgcn_s_sleep(1); \
    if ((++_sp & 255u) == 0u) { if (xb_ld(&(bar)[XB_TMO])) break; if (_sp > XB_SPIN_CAP) { atomicAdd(&(bar)[XB_TMO], 1u); break; } } } } while (0)

struct XcdBarrier {
    unsigned* bar; unsigned x;
    volatile LAS unsigned* st;
};

__device__ __forceinline__ XcdBarrier xcd_barrier_post(unsigned* bar, volatile LAS unsigned* st) {
    XcdBarrier b; b.bar = bar; b.x = xb_xcc_id(); b.st = st;
    if (threadIdx.x == 0) (void)xb_add(&bar[XB_XCNT(b.x)], 1u);
    return b;
}
__device__ __forceinline__ void xcd_barrier_complete(unsigned* bar, unsigned x, unsigned& nloc, unsigned& nx) {
    const unsigned G = gridDim.x * gridDim.y * gridDim.z;
    unsigned sum, cnt, mine, sp = 0u;
    for (;;) {
        sum = 0u; cnt = 0u; mine = 0u;
#pragma unroll
        for (unsigned j = 0; j < 16; ++j) { const unsigned c = xb_ld(&bar[XB_XCNT(j)]); sum += c; cnt += (c > 0u) ? 1u : 0u; mine = (j == x) ? c : mine; }
        if (sum == G) break;
        __builtin_amdgcn_s_sleep(1);
        if ((++sp & 255u) == 0u) { if (xb_ld(&bar[XB_TMO])) break; if (sp > XB_SPIN_CAP) { atomicAdd(&bar[XB_TMO], 1u); break; } }
    }
    nloc = mine > 0u ? mine : 1u; nx = cnt > 0u ? cnt : 1u;
}

__device__ __forceinline__ void xcd_barrier(const XcdBarrier& b) {
    asm volatile("s_waitcnt vmcnt(0)" ::: "memory");
    __syncthreads();
    if (threadIdx.x == 0) {
        unsigned* bar = b.bar;
        __builtin_amdgcn_s_waitcnt(0);
        unsigned nloc = b.st[0], nx = b.st[1];
        if (nloc == 0u) { xcd_barrier_complete(bar, b.x, nloc, nx); b.st[0] = nloc; b.st[1] = nx; }
        const unsigned old = xb_add(&bar[XB_XSUB(b.x)], 1u);
        const unsigned gen = old / nloc;
        if (old + 1u == (gen + 1u) * nloc) {
            __builtin_amdgcn_fence(__ATOMIC_RELEASE, "agent");
            asm volatile("s_waitcnt vmcnt(0)" ::: "memory");
            const unsigned og = xb_add(&bar[XB_TOP], 1u);
            const unsigned tg = og / nx;
            if (og + 1u == (tg + 1u) * nx) xb_add(&bar[XB_TOPGEN], 1u);
            else XB_SPIN(xb_ld(&bar[XB_TOPGEN]) == tg, bar);
            __builtin_amdgcn_fence(__ATOMIC_ACQUIRE, "agent");
            xb_add(&bar[XB_XGEN(b.x)], 1u);
            asm volatile("s_waitcnt vmcnt(0)" ::: "memory");
        } else {
            XB_SPIN(xb_ld(&bar[XB_XGEN(b.x)]) == gen, bar);
            __builtin_amdgcn_fence(__ATOMIC_ACQUIRE, "agent");
            asm volatile("s_waitcnt vmcnt(0)" ::: "memory");
        }
    }
    __syncthreads();
}

struct Args { const float* in[32]; float* out; unsigned char* ws; int ph_lo, ph_hi; };
struct Frame {
    LAS unsigned char* lds;
    volatile LAS unsigned* MISC;
    gu32* ctl;
    int tid, lane, wave;
    int vcu, G;
};


__device__ __forceinline__ void s5_lane_params(const Args& a, int g, int n, float& lr, float& li, float& fr, float& fi) {
    const float dt = expf(a.in[8][g]);
    const float ar = a.in[9][g * NS + n], ai = a.in[10][g * NS + n];
    const float mag = expf(ar * dt), ang = ai * dt;
    lr = mag * cosf(ang); li = mag * sinf(ang);
    const float den = ar * ar + ai * ai;
    fr = ((lr - 1.f) * ar + li * ai) / den; fi = (li * ar - (lr - 1.f) * ai) / den;
}
__device__ __forceinline__ void s5_tab_kp_item(const Args& a, unsigned char* ws, LAS float* scr, int item, int lane) {
    const int g = item >> 6, k = item & 63, n = lane;
    float lr, li, fr, fi; s5_lane_params(a, g, n, lr, li, fr, fi);
    float pr = 1.f, pi = 0.f;
    for (int q = 0; q < k; ++q) { const float t = pr * lr - pi * li; pi = pr * li + pi * lr; pr = t; }
    const float* bre = a.in[11] + (size_t)(g * NS + n) * GC; const float* bim = a.in[12] + (size_t)(g * NS + n) * GC;
#pragma unroll
    for (int ci = 0; ci < 16; ++ci) { const float br = bre[ci], bi = bim[ci]; const float Br = fr * br - fi * bi, Bi = fr * bi + fi * br;
        scr[n * 16 + ci] = pr * Br - pi * Bi; scr[1024 + n * 16 + ci] = pr * Bi + pi * Br; }
    LDS_WAIT(); asm volatile("" ::: "memory");
    {
        const int ci = lane & 15; bf16* KT = (bf16*)(ws + WS_KT);
#pragma unroll
        for (int jj = 0; jj < 4; ++jj) { const int co = (lane >> 4) + 4 * jj; const float* cr = a.in[13] + (size_t)(g * GC + co) * NS; const float* cim = a.in[14] + (size_t)(g * GC + co) * NS;
            float s = 0.f;
            for (int m = 0; m < 64; ++m) s += cr[m] * scr[m * 16 + ci] - cim[m] * scr[1024 + m * 16 + ci];
            KT[((size_t)(g * 64 + k) * 16 + co) * 16 + ci] = (bf16)f2bf(s); }
    }
    {
        const int j = 63 - k, h = lane >> 5;
#pragma unroll
        for (int rb = 0; rb < 4; ++rb) { const int row = rb * 32 + (lane & 31), n2 = row & 63, isim = row >> 6; const LAS float* s = scr + isim * 1024 + n2 * 16 + 8 * h;
            v4u o; o.x = pk2(s[0], s[1]); o.y = pk2(s[2], s[3]); o.z = pk2(s[4], s[5]); o.w = pk2(s[6], s[7]);
            *(GAS v4u*)(ws + WS_PF + ((((size_t)(g * 4 + rb) * 64 + j) * 64 + lane) * 16)) = o; }
    }
    LDS_WAIT(); asm volatile("" ::: "memory");
}
__device__ __forceinline__ void s5_tab_r_item(const Args& a, unsigned char* ws, LAS float* scr, int item, int lane) {
    const int g = item >> 5, rb = item & 31, n = lane;
    float lr, li, fr, fi; s5_lane_params(a, g, n, lr, li, fr, fi);
    float pr = lr, pi = li;
    for (int q = 0; q < 2 * rb; ++q) { const float t = pr * lr - pi * li; pi = pr * li + pi * lr; pr = t; }
    const float p2r = pr * lr - pi * li, p2i = pr * li + pi * lr;
#pragma unroll
    for (int co = 0; co < 16; ++co) { const float cr = a.in[13][(size_t)(g * GC + co) * NS + n], ci = a.in[14][(size_t)(g * GC + co) * NS + n];
        scr[(0 * 16 + co) * 64 + n] = cr * pr - ci * pi;   scr[2048 + (0 * 16 + co) * 64 + n] = -(cr * pi + ci * pr);
        scr[(1 * 16 + co) * 64 + n] = cr * p2r - ci * p2i; scr[2048 + (1 * 16 + co) * 64 + n] = -(cr * p2i + ci * p2r); }
    LDS_WAIT(); asm volatile("" ::: "memory");
    const int i2 = (lane & 31) >> 4, co = lane & 15, h = lane >> 5;
#pragma unroll
    for (int ks = 0; ks < 8; ++ks) { const LAS float* s = scr + (ks >> 2) * 2048 + (i2 * 16 + co) * 64 + (ks & 3) * 16 + 8 * h;
        v4u o; o.x = pk2(s[0], s[1]); o.y = pk2(s[2], s[3]); o.z = pk2(s[4], s[5]); o.w = pk2(s[6], s[7]);
        *(GAS v4u*)(ws + WS_RF + ((((size_t)(g * 32 + rb) * 8 + ks) * 64 + lane) * 16)) = o; }
    LDS_WAIT(); asm volatile("" ::: "memory");
}

constexpr int S5_US = 0, S5_KT = 65536, S5_ES = 98304, S5_SP = 114688, S5_LAM = 122880;
#define S5_BAR() do { asm volatile("s_waitcnt vmcnt(0) lgkmcnt(0)" ::: "memory"); __builtin_amdgcn_s_barrier(); asm volatile("" ::: "memory"); } while (0)
__device__ __forceinline__ void s5_item(Frame& F, const Args& a, int b, int g) {
    unsigned char* ws = a.ws;
    LAS unsigned char* L = F.lds + RING_OFF;
    const int tid = F.tid, lane = F.lane, w = F.wave, r32 = lane & 31, hi = lane >> 5;
    {
        const bf16* U = (const bf16*)(ws + WS_U) + ((size_t)b * SEQ) * SSMW + g * GC;
#pragma unroll
        for (int i = 0; i < 8; ++i) { const int p = tid + 512 * i, t = p >> 1, hf = p & 1;
            const v4u v = *(const GAS v4u*)(U + (size_t)t * SSMW + 8 * hf);
            *(LAS v4u*)(L + S5_US + (((t & 63) * 32 + (t >> 6)) * 16 + 8 * hf) * 2) = v; }
        const GAS v4u* kt = (const GAS v4u*)(ws + WS_KT + (size_t)g * 32768);
#pragma unroll
        for (int i = 0; i < 4; ++i) *(LAS v4u*)(L + S5_KT + (tid + 512 * i) * 16) = kt[tid + 512 * i];
        if (w == 0) { float lr, li, fr, fi; s5_lane_params(a, g, lane, lr, li, fr, fi);
            float pr = lr, pi = li;
#pragma unroll
            for (int q = 0; q < 6; ++q) { const float t = pr * pr - pi * pi; pi = 2.f * pr * pi; pr = t; }
            ((LAS float*)(L + S5_LAM))[lane] = pr; ((LAS float*)(L + S5_LAM))[64 + lane] = pi; }
    }
    S5_BAR();
    if (w < 4) {
        f32x16 acc = {};
        const GAS bf16x8* pf = (const GAS bf16x8*)(ws + WS_PF) + ((size_t)(g * 4 + w) * 64) * 64 + lane;
        const LAS unsigned char* ub = L + S5_US + r32 * 32 + hi * 16;
#pragma unroll 8
        for (int j = 0; j < 64; ++j) { const bf16x8 A = pf[(size_t)j * 64]; const bf16x8 B = *(const LAS bf16x8*)(ub + j * 1024);
            acc = __builtin_amdgcn_mfma_f32_32x32x16_bf16(A, B, acc, 0, 0, 0); }
        LAS float* Es = (LAS float*)(L + S5_ES);
#pragma unroll
        for (int r = 0; r < 16; ++r) Es[(w * 32 + (r & 3) + 8 * (r >> 2) + 4 * hi) * 32 + r32] = acc[r];
    }
    S5_BAR();
    if (w == 0) {
        const LAS float* Es = (const LAS float*)(L + S5_ES); const float l64r = ((LAS float*)(L + S5_LAM))[lane], l64i = ((LAS float*)(L + S5_LAM))[64 + lane];
        LAS bf16* Sp = (LAS bf16*)(L + S5_SP);
        float sr = 0.f, si = 0.f; const int n = lane;
        for (int c = 0; c < 32; ++c) {
            Sp[(((n >> 4) * 32 + c) * 16 + (n & 15))] = (bf16)f2bf(sr);
            Sp[((((64 + n) >> 4) * 32 + c) * 16 + (n & 15))] = (bf16)f2bf(si);
            const float er = Es[n * 32 + c], ei = Es[(64 + n) * 32 + c];
            const float t = l64r * sr - l64i * si + er; si = l64r * si + l64i * sr + ei; sr = t;
        }
    }
    S5_BAR();
    {
        const float* Dg = a.in[15] + g * GC;
        float dv[2][4];
#pragma unroll
        for (int q = 0; q < 2; ++q)
#pragma unroll
            for (int e = 0; e < 4; ++e) dv[q][e] = Dg[e + 8 * q + 4 * hi];
        bf16* YS = (bf16*)(ws + WS_YS) + ((size_t)b * SEQ) * SSMW + g * GC;
        const LAS unsigned char* ub = L + S5_US + r32 * 32 + hi * 16;
        const LAS unsigned char* sb = L + S5_SP + r32 * 32 + hi * 16;
#pragma unroll 1
        for (int q4 = 0; q4 < 4; ++q4) {
            const int rb = (q4 == 0) ? w : (q4 == 1) ? 15 - w : (q4 == 2) ? 16 + w : 31 - w;
            f32x16 acc = {};
            const GAS bf16x8* rf = (const GAS bf16x8*)(ws + WS_RF) + ((size_t)(g * 32 + rb) * 8) * 64 + lane;
#pragma unroll
            for (int ks = 0; ks < 8; ++ks) { const bf16x8 A = rf[(size_t)ks * 64]; const bf16x8 B = *(const LAS bf16x8*)(sb + ks * 1024);
                acc = __builtin_amdgcn_mfma_f32_32x32x16_bf16(A, B, acc, 0, 0, 0); }
            const int irow = 2 * rb + (r32 >> 4), co = r32 & 15;
            const int nj = 2 * rb + 2;
#pragma unroll 4
            for (int j = 0; j < nj; ++j) { const int kidx = irow - j; const int kk = kidx < 0 ? 0 : kidx;
                bf16x8 A = *(const LAS bf16x8*)(L + S5_KT + (kk * 16 + co) * 32 + hi * 16);
                if (kidx < 0) A = (bf16x8){0, 0, 0, 0, 0, 0, 0, 0};
                const bf16x8 B = *(const LAS bf16x8*)(ub + j * 1024);
                acc = __builtin_amdgcn_mfma_f32_32x32x16_bf16(A, B, acc, 0, 0, 0); }
#pragma unroll
            for (int ib = 0; ib < 2; ++ib)
#pragma unroll
                for (int q = 0; q < 2; ++q) { const int i = 2 * rb + ib, co0 = 8 * q + 4 * hi;
                    const LAS bf16* up = (const LAS bf16*)(L + S5_US) + (i * 32 + r32) * 16 + co0;
                    float y[4];
#pragma unroll
                    for (int e = 0; e < 4; ++e) { float v = acc[ib * 8 + q * 4 + e] + dv[q][e] * bf2f(up[e]);
                        const float inner = 0.7978845608028654f * (v + 0.044715f * v * v * v);
                        y[e] = v * __builtin_amdgcn_rcpf(1.0f + __builtin_amdgcn_exp2f(-2.0f * 1.4426950408889634f * inner)); }
                    v2u o; o.x = pk2(y[0], y[1]); o.y = pk2(y[2], y[3]);
                    *(GAS v2u*)(YS + (size_t)(64 * r32 + i) * SSMW + co0) = o; }
        }
    }
    S5_BAR();
}

namespace att {
constexpr int KS = 400, VS = 320;
constexpr int KBUF = 64 * KS, VBUF = 64 * VS;
constexpr int L_K = 0, L_V = 2 * KBUF, L_SCR = L_V + 2 * VBUF, L_QX = L_SCR + 8 * 256, L_END = L_QX + 8 * 4096;
static_assert(L_END <= RING_BYTES && 8 * 8192 <= L_SCR, "attention LDS map");
typedef short v4i16_t __attribute__((ext_vector_type(4)));
typedef short s16x4 __attribute__((ext_vector_type(4)));
__device__ __forceinline__ s16x4 vtr(const LAS unsigned char* p) { return __builtin_bit_cast(s16x4, __builtin_amdgcn_ds_read_tr16_b64_v4i16((LAS v4i16_t*)p)); }
__device__ __forceinline__ int crow(int r, int hi) { return (r & 3) + 8 * (r >> 2) + 4 * hi; }
__device__ __forceinline__ unsigned cvtpk(float lo, float hi) { unsigned r; asm volatile("v_cvt_pk_bf16_f32 %0, %1, %2" : "=v"(r) : "v"(lo), "v"(hi)); return r; }
#define ATT_BAR() do { asm volatile("s_waitcnt vmcnt(0) lgkmcnt(0)" ::: "memory"); __builtin_amdgcn_s_barrier(); asm volatile("" ::: "memory"); } while (0)

__device__ __forceinline__ void attn_unit(Frame& F, const Args& a, int bh, int qb, float negC) {
    unsigned char* ws = a.ws;
    LAS unsigned char* L = F.lds + RING_OFF;
    const int tid = F.tid, lane = F.lane, w = F.wave, r32 = lane & 31, hi = lane >> 5;
    const int c0 = qb * 4, NT = c0 + 4, my_nt = c0 + (w >> 1) + 1;
    const unsigned char* Qg = ws + WS_QH + ((size_t)bh * SEQ + qb * 256 + 32 * w) * QKH * 2;
    const unsigned char* Kg = ws + WS_KH + (size_t)bh * SEQ * QKH * 2;
    const unsigned char* Vg = ws + WS_VH + (size_t)bh * SEQ * VHD * 2;
    int kdst[3], vdst[2];
#pragma unroll
    for (int i = 0; i < 3; ++i) { const int p = tid + 512 * i; kdst[i] = (p / 24) * KS + (p % 24) * 16; }
#pragma unroll
    for (int i = 0; i < 2; ++i) { const int p = tid + 512 * i; vdst[i] = (p >> 4) * VS + (p & 15) * 16; }
    v4u kst[3], vst[2];
    const unsigned tb = (unsigned)tid * 16u;
#define ATT_LOAD(t) do { const unsigned char* kt_ = Kg + (size_t)(t) * 24576; const unsigned char* vt_ = Vg + (size_t)(t) * 16384; \
                         _Pragma("unroll") for (int i = 0; i < 3; ++i) kst[i] = *(const GAS v4u*)(kt_ + (tb + 8192u * i)); \
                         _Pragma("unroll") for (int i = 0; i < 2; ++i) vst[i] = *(const GAS v4u*)(vt_ + (tb + 8192u * i)); } while (0)
#define ATT_WRITE(buf) do { _Pragma("unroll") for (int i = 0; i < 3; ++i) *(LAS v4u*)(L + L_K + (buf) * KBUF + kdst[i]) = kst[i]; \
                            _Pragma("unroll") for (int i = 0; i < 2; ++i) *(LAS v4u*)(L + L_V + (buf) * VBUF + vdst[i]) = vst[i]; } while (0)
    ATT_LOAD(0);
    bf16x8 qf[8];
    LAS unsigned char* qx = L + L_QX + w * 4096 + lane * 16;
#pragma unroll
    for (int s = 0; s < 12; ++s) { const bf16x8 v = *(const GAS bf16x8*)(Qg + ((unsigned)(r32 * QKH + hi * 8) * 2u + 32u * s));
        if (s < 8) qf[s] = v; else *(LAS bf16x8*)(qx + (s - 8) * 1024) = v; }
    f32x16 o[4];
#pragma unroll
    for (int d = 0; d < 4; ++d) o[d] = (f32x16){};
    float lsum = 0.f;
    ATT_WRITE(0);
    ATT_BAR();
    const int koff = r32 * KS + hi * 16;
    const int voff = (4 * hi + ((lane & 15) >> 2)) * VS + (((lane >> 4) & 1) * 16 + (lane & 3) * 4) * 2;
    for (int t = 0; t < NT; ++t) {
        const int buf = t & 1;
        if (t + 1 < NT) ATT_LOAD(t + 1);
        if (t < my_nt) {
            const LAS unsigned char* Kb = L + L_K + buf * KBUF + koff;
            const LAS unsigned char* Vb = L + L_V + buf * VBUF + voff;
#pragma unroll 1
            for (int kb = 0; kb < 2; ++kb) {
                f32x16 p;
#pragma unroll
                for (int r = 0; r < 16; ++r) p[r] = negC;
#pragma unroll
                for (int s = 0; s < 12; ++s) {
                    const bf16x8 kf = *(const LAS bf16x8*)(Kb + kb * 32 * KS + s * 32);
                    const bf16x8 qv = (s < 8) ? qf[s < 8 ? s : 0] : *(const LAS bf16x8*)(qx + (s - 8) * 1024);
                    p = __builtin_amdgcn_mfma_f32_32x32x16_bf16(kf, qv, p, 0, 0, 0);
                    if (s == 3 || s == 7) __builtin_amdgcn_sched_barrier(0);
                }
                __builtin_amdgcn_sched_barrier(0);
                float sacc = 0.f;
#pragma unroll
                for (int r = 0; r < 16; ++r) { p[r] = __builtin_amdgcn_exp2f(p[r]); sacc += p[r]; }
                lsum += sacc;
                v4u pa[2];
#pragma unroll
                for (int s2 = 0; s2 < 2; ++s2)
                    pa[s2] = (v4u){cvtpk(p[8 * s2 + 0], p[8 * s2 + 1]), cvtpk(p[8 * s2 + 2], p[8 * s2 + 3]), cvtpk(p[8 * s2 + 4], p[8 * s2 + 5]), cvtpk(p[8 * s2 + 6], p[8 * s2 + 7])};
#pragma unroll
                for (int s2 = 0; s2 < 2; ++s2) {
#pragma unroll
                    for (int d = 0; d < 4; ++d) {
                        const s16x4 lo = vtr(Vb + (32 * kb + 16 * s2) * VS + d * 64), h8 = vtr(Vb + (32 * kb + 16 * s2 + 8) * VS + d * 64);
                        const bf16x8 B = (bf16x8){lo[0], lo[1], lo[2], lo[3], h8[0], h8[1], h8[2], h8[3]};
                        o[d] = __builtin_amdgcn_mfma_f32_32x32x16_bf16(__builtin_bit_cast(bf16x8, pa[s2]), B, o[d], 0, 0, 0);
                    }
                    __builtin_amdgcn_sched_barrier(0);
                }
            }
        }
        if (t + 1 < NT) ATT_WRITE(buf ^ 1);
        ATT_BAR();
    }
    lsum += __shfl_xor(lsum, 32);
    LAS float* scr = (LAS float*)(L + L_SCR + w * 256);
    if (hi == 0) scr[r32] = lsum;
    LDS_WAIT(); asm volatile("" ::: "memory");
    LAS bf16* stg = (LAS bf16*)(L + w * 8192);
#pragma unroll
    for (int r = 0; r < 16; ++r) { const int q = crow(r, hi); const float rl = __builtin_amdgcn_rcpf(scr[q]);
#pragma unroll
        for (int d = 0; d < 4; ++d) stg[q * 128 + d * 32 + r32] = (bf16)f2bf(o[d][r] * rl); }
    LDS_WAIT(); asm volatile("" ::: "memory");
    const int b = bh >> 3, h = bh & 7;
    const size_t grow0 = (size_t)b * SEQ + qb * 256 + 32 * w;
    unsigned char* Yg = ws + WS_Y + (grow0 * DM + 1024 + h * VHD) * 2;
    float* SSAo = (float*)(ws + WS_SS) + SSA * MT + grow0;
#pragma unroll
    for (int i = 0; i < 8; ++i) { const int id = i * 64 + lane, row = id >> 4, ch = id & 15;
        const v4u v = *(const LAS v4u*)((const LAS unsigned char*)stg + row * 256 + ch * 16);
        *(GAS v4u*)(Yg + (unsigned)(row * DM * 2 + ch * 16)) = v;
        float s = 0.f;
#pragma unroll
        for (int e = 0; e < 4; ++e) { const float x0 = __builtin_bit_cast(float, v[e] << 16), x1 = __builtin_bit_cast(float, v[e] & 0xffff0000u); s += x0 * x0 + x1 * x1; }
        s += __shfl_xor(s, 1); s += __shfl_xor(s, 2); s += __shfl_xor(s, 4); s += __shfl_xor(s, 8);
        if (ch == 0) atomicAdd(SSAo + row, s); }
    ATT_BAR();
#undef ATT_LOAD
#undef ATT_WRITE
}
__device__ __forceinline__ float attn_negC(const Args& a, int lane) {
    float mq = 0.f, mk = 0.f;
#pragma unroll
    for (int i = 0; i < 3; ++i) { mq = fmaxf(mq, fabsf(a.in[22][lane + 64 * i])); mk = fmaxf(mk, fabsf(a.in[23][lane + 64 * i])); }
#pragma unroll
    for (int o = 1; o < 64; o <<= 1) { mq = fmaxf(mq, __shfl_xor(mq, o)); mk = fmaxf(mk, __shfl_xor(mk, o)); }
    return -(QSCALE * 192.0f * 1.0005f) * mq * mk;
}
}
struct MapId { __device__ __forceinline__ int operator()(int n) const { return n; } };
struct MapGU { int which; __device__ __forceinline__ int operator()(int n) const { return (n >> 7) * 256 + which * 128 + (n & 127); } };
struct MapWin { __device__ __forceinline__ int operator()(int n) const { if (n < 1792) return n; const int i = n - 1792; return 1792 + 2 * (i & 31) + (i >> 5); } };
struct MapQ { __device__ __forceinline__ int operator()(int n) const { const int h = n / 192, d = n - h * 192; if (d < 128) return h * 256 + d; const int i = d - 128; return h * 256 + 128 + 2 * (i & 31) + (i >> 5); } };

template <class Map>
__device__ __forceinline__ void p0_transpose_item(const float* W, int K, int N, const float* gain, const float* gain2, int gsplit, bf16* WT, Map map, LAS float* scr, int item, int lane) {
    const int nblk = N / 32, kb = item / nblk, nb = item % nblk, k0 = 64 * kb, n0 = 32 * nb;
#pragma unroll 8
    for (int i = 0; i < 32; ++i) { const int kk = 2 * i + (lane >> 5); scr[kk * 33 + (lane & 31)] = W[(size_t)(k0 + kk) * N + n0 + (lane & 31)]; }
    const int c = lane & 7;
    float gv[8];
#pragma unroll
    for (int e = 0; e < 8; ++e) { const int k = k0 + 8 * c + e; gv[e] = gain ? ((k < gsplit) ? gain[k] : gain2[k - gsplit]) : 1.0f; }
    LDS_WAIT(); asm volatile("" ::: "memory");
#pragma unroll
    for (int j = 0; j < 4; ++j) { const int n = (lane >> 3) + 8 * j; const LAS float* s = scr + (8 * c) * 33 + n;
        v4u o; o.x = pk2(s[0 * 33] * gv[0], s[1 * 33] * gv[1]); o.y = pk2(s[2 * 33] * gv[2], s[3 * 33] * gv[3]); o.z = pk2(s[4 * 33] * gv[4], s[5 * 33] * gv[5]); o.w = pk2(s[6 * 33] * gv[6], s[7 * 33] * gv[7]);
        *(GAS v4u*)(WT + (size_t)map(n0 + n) * K + k0 + 8 * c) = o; }
    LDS_WAIT(); asm volatile("" ::: "memory");
}
__device__ __forceinline__ void row_to_bf16_ss(const float* xrow, bf16* orow, float* ss, int lane) {
    const GAS f32x4* xr = (const GAS f32x4*)xrow + lane;
    GAS v2u* o8 = (GAS v2u*)orow + lane;
    float s = 0.f;
#pragma unroll
    for (int j = 0; j < DM / 256; ++j) { const f32x4 v = xr[64 * j]; s += (v.x * v.x + v.y * v.y) + (v.z * v.z + v.w * v.w);
        v2u w; w.x = pk2(v.x, v.y); w.y = pk2(v.z, v.w); o8[64 * j] = w; }
    s = wave_sum(s);
    if (lane == 0) *ss = s;
}

__device__ __forceinline__ void p0_prologue(Frame& F, const Args& a) {
    unsigned char* ws = a.ws;
    LAS float* scr = (LAS float*)(F.lds + RING_OFF + F.wave * 16384);
    const int gw = F.vcu * NWAVES + F.wave, NGW = F.G * NWAVES;
    const int gt = F.vcu * NWAVES * 64 + F.tid, NGT = F.G * NWAVES * 64;
    constexpr int I_GU = (DM / 64) * (DFF / 32), I_D = (DFF / 64) * (DM / 32), I_IN = (DM / 64) * (DIN / 32), I_OUT = (DM / 64) * (DM / 32), I_GLU = (SSMW / 64) * (SSMW / 32),
                  I_Q = (QL / 64) * (1536 / 32), I_KV = (KVL / 64) * (2048 / 32);
    constexpr int NITEMS = 4 * I_GU + 2 * I_D + I_IN + I_OUT + I_GLU + I_Q + I_KV;
    for (int it = gw; it < NITEMS; it += NGW) {
        int r = it;
        if (r < I_GU) { p0_transpose_item(a.in[3], DM, DFF, a.in[2], a.in[2], DM, (bf16*)(ws + WS_W1GU), MapGU{0}, scr, r, F.lane); continue; } r -= I_GU;
        if (r < I_GU) { p0_transpose_item(a.in[4], DM, DFF, a.in[2], a.in[2], DM, (bf16*)(ws + WS_W1GU), MapGU{1}, scr, r, F.lane); continue; } r -= I_GU;
        if (r < I_D)  { p0_transpose_item(a.in[5], DFF, DM, nullptr, nullptr, 0, (bf16*)(ws + WS_W1D), MapId{}, scr, r, F.lane); continue; } r -= I_D;
        if (r < I_IN) { p0_transpose_item(a.in[7], DM, DIN, a.in[6], a.in[6], DM, (bf16*)(ws + WS_WIN), MapWin{}, scr, r, F.lane); continue; } r -= I_IN;
        if (r < I_Q)  { p0_transpose_item(a.in[19], QL, 1536, a.in[18], a.in[18], QL, (bf16*)(ws + WS_WQ), MapQ{}, scr, r, F.lane); continue; } r -= I_Q;
        if (r < I_KV) { p0_transpose_item(a.in[21], KVL, 2048, a.in[20], a.in[20], KVL, (bf16*)(ws + WS_WKV), MapId{}, scr, r, F.lane); continue; } r -= I_KV;
        if (r < I_GLU) { p0_transpose_item(a.in[16], SSMW, SSMW, nullptr, nullptr, 0, (bf16*)(ws + WS_WGLU), MapId{}, scr, r, F.lane); continue; } r -= I_GLU;
        if (r < I_OUT) { p0_transpose_item(a.in[26], DM, DM, a.in[24], a.in[25], SSMW, (bf16*)(ws + WS_WOUT), MapId{}, scr, r, F.lane); continue; } r -= I_OUT;
        if (r < I_GU) { p0_transpose_item(a.in[28], DM, DFF, a.in[27], a.in[27], DM, (bf16*)(ws + WS_W2GU), MapGU{0}, scr, r, F.lane); continue; } r -= I_GU;
        if (r < I_GU) { p0_transpose_item(a.in[29], DM, DFF, a.in[27], a.in[27], DM, (bf16*)(ws + WS_W2GU), MapGU{1}, scr, r, F.lane); continue; } r -= I_GU;
        p0_transpose_item(a.in[30], DFF, DM, nullptr, nullptr, 0, (bf16*)(ws + WS_W2D), MapId{}, scr, r, F.lane);
    }
    for (int it = gw; it < NG * 64; it += NGW) s5_tab_kp_item(a, ws, scr, it, F.lane);
    for (int it = gw; it < NG * 32; it += NGW) s5_tab_r_item(a, ws, scr, it, F.lane);
    { GAS v4u* p = (GAS v4u*)(ws + WS_WIN + (size_t)DIN * DM * 2); const int n16 = (DINP - DIN) * DM * 2 / 16;
      for (int i = gt; i < n16; i += NGT) p[i] = (v4u){0u, 0u, 0u, 0u}; }
    { const int per_h = 64 * QL * 2 / 16, n16 = NH * per_h;
      for (int i = gt; i < n16; i += NGT) { const int h = i / per_h, r = i - h * per_h; ((GAS v4u*)(ws + WS_WQ + (size_t)(h * 256 + 192) * QL * 2))[r] = (v4u){0u, 0u, 0u, 0u}; } }
    float* SS = (float*)(ws + WS_SS);
    for (int m = gw; m < MT; m += NGW) row_to_bf16_ss(a.in[0] + (size_t)m * DM, (bf16*)(ws + WS_XB) + (size_t)m * DM, SS + SS1 * MT + m, F.lane);
    { const int* pos = (const int*)a.in[1]; float* CS = (float*)(ws + WS_CS); float* SN = (float*)(ws + WS_SN);
      for (int i = gt; i < MT * 32; i += NGT) { const int row = i >> 5, k = i & 31; const float inv_freq = powf(10000.0f, -(float)(2 * k) / 64.0f); const float ang = (float)pos[row] * inv_freq;
          CS[i] = cosf(ang); SN[i] = sinf(ang); } }
}

constexpr int N_PHASES = 10;
__global__ void __launch_bounds__(NWAVES * 64, 2) mk_fwd(Args args) {
    extern __shared__ __attribute__((aligned(16))) unsigned char lds[];
    Frame F;
    F.lds = (LAS unsigned char*)lds;
    F.MISC = (volatile LAS unsigned*)(F.lds + MISC_OFF);
    F.tid = threadIdx.x; F.lane = F.tid & 63; F.wave = __builtin_amdgcn_readfirstlane(F.tid >> 6);
    F.G = gridDim.x; { const int bx = blockIdx.x; F.vcu = (F.G % 8 == 0) ? (bx % 8) * (F.G / 8) + bx / 8 : bx; }
    unsigned char* ws = args.ws;
    F.ctl = (gu32*)(ws + WS_CTL);
    for (int u = F.tid; u < (LDS_BYTES - LDSCTL_OFF) / 4; u += NWAVES * 64) ((LAS unsigned*)(F.lds + LDSCTL_OFF))[u] = 0u;
    __syncthreads();
    const int lo = args.ph_lo, hi = args.ph_hi;
    const bool use_bar = (hi - lo) > 1;
    XcdBarrier bar; bar.bar = (unsigned*)(F.ctl + CW_BAR); bar.x = 0; bar.st = nullptr;
    if (use_bar) bar = xcd_barrier_post((unsigned*)(F.ctl + CW_BAR), F.MISC + 8);
#define IN(k) (lo <= (k) && (k) < hi)
#define SEAM(k) do { if (IN(k) && IN((k) + 1)) xcd_barrier(bar); } while (0)
    float* SS = (float*)(ws + WS_SS);
    bf16* XB = (bf16*)(ws + WS_XB);
    bf16* HB = (bf16*)(ws + WS_H);
    float* RS = args.out;

    if (IN(0)) { p0_prologue(F, args); SEAM(0); }

    if (IN(1)) {
        pg8::Gemm g{XB, (const bf16*)(ws + WS_W1GU), MT, 2 * DFF, DM}; pg8::StaticOrder S; S.init(MT, 2 * DFF, F.G, (int)blockIdx.x);
        pg8::EpiSwiGLU E{HB, DFF, SS + SS1 * MT, 1.0f / DM};
        pg8::gemm_phase<pg8::EpiSwiGLU, pg8::StaticOrder, true, true>(F.lds + RING_OFF, g, S, E);
        SEAM(1);
    }
    if (IN(2)) {
        pg8::Gemm g{HB, (const bf16*)(ws + WS_W1D), MT, DM, DFF}; pg8::StaticOrder S; S.init(MT, DM, F.G, (int)blockIdx.x);
        pg8::EpiResid E{args.in[0], RS, XB, SS + SS2 * MT, 0.5f, DM};
        pg8::gemm_phase<pg8::EpiResid, pg8::StaticOrder, true, true>(F.lds + RING_OFF, g, S, E);
        SEAM(2);
    }
    if (IN(3)) {
        pg8::Gemm g{XB, (const bf16*)(ws + WS_WIN), MT, DINP, DM}; pg8::StaticOrder S; S.init(MT, DINP, F.G, (int)blockIdx.x);
        pg8::EpiWin E{SS + SS2 * MT, (bf16*)(ws + WS_U), (bf16*)(ws + WS_QLAT), (bf16*)(ws + WS_KVLAT), (float*)(ws + WS_KPE), SS + SSQ * MT, SS + SSKV * MT};
        pg8::gemm_phase<pg8::EpiWin, pg8::StaticOrder, true, true>(F.lds + RING_OFF, g, S, E);
        SEAM(3);
    }
    if (IN(4)) {
        if (F.G == 256) {
            {
                pg8::Gemm g{(const bf16*)(ws + WS_QLAT), (const bf16*)(ws + WS_WQ), MT, QUPP, QL}; pg8::StaticOrder S; S.init(MT, QUPP, F.G, (int)blockIdx.x);
                pg8::EpiQ E{SS + SSQ * MT, args.in[22], (const float*)(ws + WS_CS), (const float*)(ws + WS_SN), (bf16*)(ws + WS_QH), QSCALE};
                pg8::gemm_phase<pg8::EpiQ, pg8::StaticOrder, false, true>(F.lds + RING_OFF, g, S, E);
            }
            {
                pg8::Gemm g{(const bf16*)(ws + WS_KVLAT), (const bf16*)(ws + WS_WKV), MT, KVUP, KVL}; pg8::StaticOrder S; S.init(MT, KVUP, F.G, (int)blockIdx.x);
                pg8::EpiKV E{SS + SSKV * MT, args.in[23], (const float*)(ws + WS_KPE), (const float*)(ws + WS_CS), (const float*)(ws + WS_SN), (bf16*)(ws + WS_KH), (bf16*)(ws + WS_VH)};
                pg8::gemm_phase<pg8::EpiKV, pg8::StaticOrder, false, true>(F.lds + RING_OFF, g, S, E);
            }
            s5_item(F, args, F.vcu & 3, F.vcu >> 2);
        }
        SEAM(4);
    }
    if (IN(5)) {
        if (F.G == 256) {
            if (F.vcu < 128) {
                const float negC = att::attn_negC(args, F.lane);
                const int bh = F.vcu >> 2, s = F.vcu & 3;
#pragma unroll 1
                for (int u2 = 0; u2 < 2; ++u2) att::attn_unit(F, args, bh, u2 ? 7 - s : s, negC);
            } else {
                pg8::Gemm g{(const bf16*)(ws + WS_YS), (const bf16*)(ws + WS_WGLU), MT, SSMW, SSMW}; pg8::StaticOrder S; S.init(MT, SSMW, 128, F.vcu - 128);
                pg8::EpiGLU E{(const bf16*)(ws + WS_YS), args.in[17], (bf16*)(ws + WS_Y), DM, SS + SSS * MT};
                pg8::gemm_phase<pg8::EpiGLU, pg8::StaticOrder, true, true>(F.lds + RING_OFF, g, S, E);
            }
        }
        SEAM(5);
    }
    if (IN(6)) {
        pg8::Gemm g{(const bf16*)(ws + WS_Y), (const bf16*)(ws + WS_WOUT), MT, DM, DM}; pg8::StaticOrder S; S.init(MT, DM, F.G, (int)blockIdx.x);
        pg8::EpiWout E{SS + SSS * MT, SS + SSA * MT, RS, XB, SS + SS3 * MT, DM};
        pg8::gemm_phase<pg8::EpiWout, pg8::StaticOrder, true, true>(F.lds + RING_OFF, g, S, E);
        SEAM(6);
    }
    if (IN(7)) {
        pg8::Gemm g{XB, (const bf16*)(ws + WS_W2GU), MT, 2 * DFF, DM}; pg8::StaticOrder S; S.init(MT, 2 * DFF, F.G, (int)blockIdx.x);
        pg8::EpiSwiGLU E{HB, DFF, SS + SS3 * MT, 1.0f / DM};
        pg8::gemm_phase<pg8::EpiSwiGLU, pg8::StaticOrder, true, true>(F.lds + RING_OFF, g, S, E);
        SEAM(7);
    }
    if (IN(8)) {
        pg8::Gemm g{HB, (const bf16*)(ws + WS_W2D), MT, DM, DFF}; pg8::StaticOrder S; S.init(MT, DM, F.G, (int)blockIdx.x);
        pg8::EpiResid E{RS, RS, nullptr, SS + SS4 * MT, 0.5f, DM};
        pg8::gemm_phase<pg8::EpiResid, pg8::StaticOrder, true, true>(F.lds + RING_OFF, g, S, E);
        SEAM(8);
    }
    if (IN(9)) {
        const int gw = F.vcu * NWAVES + F.wave, NGW = F.G * NWAVES;
        const float* gfin = args.in[31];
        for (int m = gw; m < MT; m += NGW) {
            const float rs = rsqrtf(SS[SS4 * MT + m] * (1.0f / DM) + EPS);
            GAS f32x4* p = (GAS f32x4*)(RS + (size_t)m * DM) + F.lane;
#pragma unroll
            for (int j = 0; j < DM / 256; ++j) { const f32x4 v = p[64 * j]; const f32x4 gg = ((const GAS f32x4*)gfin)[64 * j + F.lane]; p[64 * j] = v * gg * rs; }
        }
    }
#undef IN
#undef SEAM
}

#ifndef MK_N_LAUNCHES
#define MK_N_LAUNCHES 1
#endif
extern "C" void kernel_launch(void* const* d_in, const int* in_sizes, int n_in, void* d_out, int out_size, void* d_ws, size_t ws_size, hipStream_t stream) {
    static int grid = 0;
    if (grid == 0) {
        if (n_in != 32 || out_size != MT * DM || ws_size < WS_END) { fprintf(stderr, "kernel_launch: unexpected shapes / workspace (n_in %d out %d ws %zu need %zu)\n", n_in, out_size, ws_size, (size_t)WS_END); grid = -1; return; }
        int dev = 0, cus = 0;
        if (hipGetDevice(&dev) != hipSuccess || hipDeviceGetAttribute(&cus, hipDeviceAttributeMultiprocessorCount, dev) != hipSuccess) { grid = -1; return; }
        if (hipFuncSetAttribute((const void*)mk_fwd, hipFuncAttributeMaxDynamicSharedMemorySize, LDS_BYTES) != hipSuccess) { fprintf(stderr, "kernel_launch: hipFuncSetAttribute failed\n"); grid = -1; return; }
        int per_cu = 0;
        if (hipOccupancyMaxActiveBlocksPerMultiprocessor(&per_cu, (const void*)mk_fwd, NWAVES * 64, LDS_BYTES) != hipSuccess || per_cu < 1)
            fprintf(stderr, "kernel_launch: note: occupancy query reports %d workgroups per CU\n", per_cu);
        (void)hipGetLastError();
        grid = cus;
        if (grid != 256) { fprintf(stderr, "kernel_launch: built for a 256-CU device (got %d)\n", grid); grid = -1; return; }
    }
    if (grid < 0) return;
    (void)hipMemsetAsync((char*)d_ws + WS_CTL, 0, CTL_ZERO_BYTES, stream);
    Args a{};
    for (int i = 0; i < 32; ++i) a.in[i] = (const float*)d_in[i];
    a.out = (float*)d_out; a.ws = (unsigned char*)d_ws;
    if (MK_N_LAUNCHES == 1) {
        a.ph_lo = 0; a.ph_hi = N_PHASES;
        hipLaunchKernelGGL(mk_fwd, dim3(grid), dim3(NWAVES * 64), LDS_BYTES, stream, a);
    } else {
        for (int p = 0; p < N_PHASES; ++p) { a.ph_lo = p; a.ph_hi = p + 1; hipLaunchKernelGGL(mk_fwd, dim3(grid), dim3(NWAVES * 64), LDS_BYTES, stream, a); }
    }
}
```

```cpp
#include <hip/hip_runtime.h>
#include <cstdio>
#include <cstdint>
#include <math.h>
namespace pg8 {
#define PG8_LAS __attribute__((address_space(3)))
typedef unsigned short bf16_t;
typedef short bf16x8 __attribute__((ext_vector_type(8)));
typedef float f32x4 __attribute__((ext_vector_type(4)));
typedef unsigned u32x4 __attribute__((ext_vector_type(4)));
constexpr int BM = 256, BK = 64, HALF = 128, HTB = HALF * BK * 2  , STAGE_BYTES = 8 * HTB, NXCD = 8, WGM = 8;

__host__ __device__ __forceinline__ int lds_byte(int r, int c) { const int st = (r >> 4) * 2 + (c >> 5), rr = r & 15, cc = c & 31, ob = rr * 64 + cc * 2; return st * 1024 + (ob ^ (((ob >> 9) & 1) << 5)); }
__host__ __device__ __forceinline__ void stage_rc(int b, int& R, int& C) { const int st = b / 1024, sb = b % 1024, swz = sb ^ (((sb >> 9) & 1) << 5); R = (st >> 1) * 16 + swz / 64; C = (st & 1) * 32 + (swz % 64) / 2; }
__host__ __device__ __forceinline__ int perm32(int rho) { const int n = rho >> 4, i = rho & 15; return 8 * (i >> 2) + 4 * n + (i & 3); }

struct Unit { int pm, pn; };
struct Gemm { const bf16_t* A; const bf16_t* Bt; int M, N, K; };

struct StaticOrder {
    int nM, nN, nwg, G, c;
    __host__ __device__ void init(int M, int N, int G_, int c_) { nM = M / BM; nN = N / BM; nwg = nM * nN; G = G_; c = c_; }
    __host__ __device__ bool next(int i, Unit& u) const {
        const long L = (long)i * G + c; if (L >= nwg) return false;
        int wgid = (int)L; { const int q = nwg / NXCD, r = nwg % NXCD, xcd = wgid % NXCD, off = wgid / NXCD; wgid = (xcd < r ? xcd * (q + 1) : r * (q + 1) + (xcd - r) * q) + off; }
        const int nig = WGM * nN, gid = wgid / nig, fm = gid * WGM, gsz = (nM - fm) < WGM ? (nM - fm) : WGM;
        u.pm = fm + ((wgid % nig) % gsz); u.pn = (wgid % nig) / gsz; return true;
    }
    __device__ __forceinline__ void a_ready(const Unit&) const {}
    __device__ __forceinline__ void done(const Unit&) const {}
};

__device__ __forceinline__ unsigned cvt_pk_bf16(float lo, float hi) { unsigned r; asm volatile("v_cvt_pk_bf16_f32 %0, %1, %2" : "=v"(r) : "v"(lo), "v"(hi)); return r; }
constexpr float RMS_EPS = 1e-6f;
__device__ __forceinline__ float rstd_of(float ss, float inv_dim) { return rsqrtf(ss * inv_dim + RMS_EPS); }
__device__ __forceinline__ float fq_sum(float v) { v += __shfl_xor(v, 16); v += __shfl_xor(v, 32); return v; }

struct EpiSwiGLU {
    static constexpr bool PERM = true, AFTER_DRAIN = false, HAS_MID = false;
    bf16_t* H; int ldh; const float* SS; float inv_dim;
    __device__ __forceinline__ void operator()(const f32x4 (&acc)[2][2][4][2], const Unit& u, int wr, int wc, int fr, int fq) const {
        const int row0 = u.pm * BM + wr * 64 + fr, col0 = u.pn * HALF + wc * 32 + 8 * fq;
#pragma unroll
        for (int ai = 0; ai < 2; ++ai)
#pragma unroll
            for (int m = 0; m < 4; ++m) {
                const int row = row0 + ai * HALF + m * 16;
                const float rs = rstd_of(SS[row], inv_dim);
                float h[8];
#pragma unroll
                for (int n = 0; n < 2; ++n)
#pragma unroll
                    for (int j = 0; j < 4; ++j) {
                        const float g = acc[ai][0][m][n][j] * rs, up = acc[ai][1][m][n][j] * rs;
                        const float e = __builtin_amdgcn_exp2f(-1.4426950408889634f * g);
                        h[n * 4 + j] = g * __builtin_amdgcn_rcpf(1.0f + e) * up;
                    }
                u32x4 w; w.x = cvt_pk_bf16(h[0], h[1]); w.y = cvt_pk_bf16(h[2], h[3]); w.z = cvt_pk_bf16(h[4], h[5]); w.w = cvt_pk_bf16(h[6], h[7]);
                *(u32x4*)(H + (size_t)row * ldh + col0) = w;
            }
    }
};

struct EpiResid {
    static constexpr bool PERM = true, AFTER_DRAIN = false, HAS_MID = false;
    const float* base; float* out; bf16_t* xb; float* SSo; float alpha; int ld;
    __device__ __forceinline__ void operator()(const f32x4 (&acc)[2][2][4][2], const Unit& u, int wr, int wc, int fr, int fq) const {
        const int row0 = u.pm * BM + wr * 64 + fr, col0 = u.pn * BM + wc * 32 + 8 * fq;
#pragma unroll
        for (int ai = 0; ai < 2; ++ai)
#pragma unroll
            for (int m = 0; m < 4; ++m) {
                const int row = row0 + ai * HALF + m * 16;
                float ssq = 0.f;
#pragma unroll
                for (int bj = 0; bj < 2; ++bj) {
                    const size_t off = (size_t)row * ld + col0 + bj * HALF;
                    const f32x4 b0 = *(const f32x4*)(base + off), b1 = *(const f32x4*)(base + off + 4);
                    const f32x4 v0 = b0 + acc[ai][bj][m][0] * alpha, v1 = b1 + acc[ai][bj][m][1] * alpha;
                    *(f32x4*)(out + off) = v0; *(f32x4*)(out + off + 4) = v1;
                    ssq += (v0[0] * v0[0] + v0[1] * v0[1]) + (v0[2] * v0[2] + v0[3] * v0[3]) + (v1[0] * v1[0] + v1[1] * v1[1]) + (v1[2] * v1[2] + v1[3] * v1[3]);
                    if (xb) { u32x4 w; w.x = cvt_pk_bf16(v0[0], v0[1]); w.y = cvt_pk_bf16(v0[2], v0[3]); w.z = cvt_pk_bf16(v1[0], v1[1]); w.w = cvt_pk_bf16(v1[2], v1[3]);
                        *(u32x4*)(xb + off) = w; }
                }
                ssq = fq_sum(ssq);
                if (fq == 0) atomicAdd(SSo + row, ssq);
            }
    }
};

struct EpiWin {
    static constexpr bool PERM = true, AFTER_DRAIN = false, HAS_MID = false;
    const float* SSin; bf16_t* U; bf16_t* QLAT; bf16_t* KVLAT; float* KPE; float* SSQo; float* SSKVo;
    __device__ __forceinline__ void operator()(const f32x4 (&acc)[2][2][4][2], const Unit& u, int wr, int wc, int fr, int fq) const {
        const int row0 = u.pm * BM + wr * 64 + fr, cl = wc * 32 + 8 * fq, pn = u.pn;
#pragma unroll
        for (int ai = 0; ai < 2; ++ai)
#pragma unroll
            for (int m = 0; m < 4; ++m) {
                const int row = row0 + ai * HALF + m * 16;
                const float rs = rstd_of(SSin[row], 1.0f / 2048.0f);
                float ssq = 0.f;
#pragma unroll
                for (int bj = 0; bj < 2; ++bj) {
                    const int tc = bj * HALF + cl;
                    const f32x4 v0 = acc[ai][bj][m][0] * rs, v1 = acc[ai][bj][m][1] * rs;
                    u32x4 w; w.x = cvt_pk_bf16(v0[0], v0[1]); w.y = cvt_pk_bf16(v0[2], v0[3]); w.z = cvt_pk_bf16(v1[0], v1[1]); w.w = cvt_pk_bf16(v1[2], v1[3]);
                    ssq += (v0[0] * v0[0] + v0[1] * v0[1]) + (v0[2] * v0[2] + v0[3] * v0[3]) + (v1[0] * v1[0] + v1[1] * v1[1]) + (v1[2] * v1[2] + v1[3] * v1[3]);
                    if (pn < 4) *(u32x4*)(U + (size_t)row * 1024 + pn * 256 + tc) = w;
                    else if (pn < 6) *(u32x4*)(QLAT + (size_t)row * 512 + (pn - 4) * 256 + tc) = w;
                    else if (pn == 6) *(u32x4*)(KVLAT + (size_t)row * 256 + tc) = w;
                    else if (tc < 64) { *(f32x4*)(KPE + (size_t)row * 64 + tc) = v0; *(f32x4*)(KPE + (size_t)row * 64 + tc + 4) = v1; }
                }
                if (pn >= 4 && pn < 7) { ssq = fq_sum(ssq); if (fq == 0) atomicAdd((pn < 6 ? SSQo : SSKVo) + row, ssq); }
            }
    }
};

#define PG8_EPI_BAR() do { asm volatile("s_waitcnt lgkmcnt(0)" ::: "memory"); __builtin_amdgcn_s_barrier(); asm volatile("" ::: "memory"); } while (0)
struct EpiQ {
    static constexpr bool PERM = true, AFTER_DRAIN = true, HAS_MID = false;
    const float* SSQ; const float* gq; const float* CS; const float* SN; bf16_t* QH; float qscale;
    __device__ __forceinline__ void fused(f32x4 (&acc)[2][2][4][2], const Unit& u, int wr, int wc, int fr, int fq, PG8_LAS unsigned char* lds, int wid, int lane) const {
        PG8_LAS float* P = (PG8_LAS float*)lds;
        const int h = u.pn;
#pragma unroll
        for (int ai = 0; ai < 2; ++ai)
#pragma unroll
            for (int m = 0; m < 4; ++m) {
                const int rt = ai * HALF + wr * 64 + m * 16 + fr, grow = u.pm * BM + rt;
                const float rs = rstd_of(SSQ[grow], 1.0f / 512.0f);
                float s = 0.f;
#pragma unroll
                for (int bj = 0; bj < 2; ++bj)
#pragma unroll
                    for (int n = 0; n < 2; ++n) { f32x4 v = acc[ai][bj][m][n] * rs; acc[ai][bj][m][n] = v; s += (v[0] * v[0] + v[1] * v[1]) + (v[2] * v[2] + v[3] * v[3]); }
                s = fq_sum(s);
                if (fq == 0) P[rt * 4 + wc] = s;
            }
        PG8_EPI_BAR();
#pragma unroll
        for (int ai = 0; ai < 2; ++ai)
#pragma unroll
            for (int m = 0; m < 4; ++m) {
                const int rt = ai * HALF + wr * 64 + m * 16 + fr, grow = u.pm * BM + rt;
                const f32x4 pp = *(const PG8_LAS f32x4*)(P + rt * 4);
                const float r192 = rsqrtf(((pp[0] + pp[1]) + (pp[2] + pp[3])) * (1.0f / 192.0f) + RMS_EPS) * qscale;
                bf16_t* dst = QH + ((size_t)((grow >> 11) * 8 + h) * 2048 + (grow & 2047)) * 192;
                {
                    const int c = wc * 32 + 8 * fq;
                    const f32x4 g0 = *(const f32x4*)(gq + c), g1 = *(const f32x4*)(gq + c + 4);
                    const f32x4 v0 = acc[ai][0][m][0] * g0 * r192, v1 = acc[ai][0][m][1] * g1 * r192;
                    u32x4 w; w.x = cvt_pk_bf16(v0[0], v0[1]); w.y = cvt_pk_bf16(v0[2], v0[3]); w.z = cvt_pk_bf16(v1[0], v1[1]); w.w = cvt_pk_bf16(v1[2], v1[3]);
                    *(u32x4*)(dst + c) = w;
                }
                if (wc < 2) {
                    const int i0 = 16 * wc + 4 * fq;
                    const f32x4 cs = *(const f32x4*)(CS + (size_t)grow * 32 + i0), sn = *(const f32x4*)(SN + (size_t)grow * 32 + i0);
                    const f32x4 ga = *(const f32x4*)(gq + 128 + i0), gb = *(const f32x4*)(gq + 160 + i0);
                    float o[8];
#pragma unroll
                    for (int p = 0; p < 4; ++p) {
                        const float x1 = acc[ai][1][m][p >> 1][2 * (p & 1)] * ga[p] * r192, x2 = acc[ai][1][m][p >> 1][2 * (p & 1) + 1] * gb[p] * r192;
                        o[2 * p] = x1 * cs[p] - x2 * sn[p]; o[2 * p + 1] = x2 * cs[p] + x1 * sn[p];
                    }
                    u32x4 w; w.x = cvt_pk_bf16(o[0], o[1]); w.y = cvt_pk_bf16(o[2], o[3]); w.z = cvt_pk_bf16(o[4], o[5]); w.w = cvt_pk_bf16(o[6], o[7]);
                    *(u32x4*)(dst + 128 + 2 * i0) = w;
                }
            }
        PG8_EPI_BAR();
    }
};
struct EpiKV {
    static constexpr bool PERM = true, AFTER_DRAIN = true, HAS_MID = false;
    const float* SSKV; const float* gk; const float* KPE; const float* CS; const float* SN; bf16_t* KH; bf16_t* VH;
    __device__ __forceinline__ void fused(f32x4 (&acc)[2][2][4][2], const Unit& u, int wr, int wc, int fr, int fq, PG8_LAS unsigned char* lds, int wid, int lane) const {
        PG8_LAS float* P = (PG8_LAS float*)lds;
        const int h = u.pn, e0 = 4 * (4 * wc + fq);
#pragma unroll
        for (int ai = 0; ai < 2; ++ai)
#pragma unroll
            for (int m = 0; m < 4; ++m) {
                const int rt = ai * HALF + wr * 64 + m * 16 + fr, grow = u.pm * BM + rt;
                const float rs = rstd_of(SSKV[grow], 1.0f / 256.0f);
                const f32x4 kp = *(const f32x4*)(KPE + (size_t)grow * 64 + e0);
                float s = (kp[0] * kp[0] + kp[1] * kp[1]) + (kp[2] * kp[2] + kp[3] * kp[3]);
#pragma unroll
                for (int bj = 0; bj < 2; ++bj)
#pragma unroll
                    for (int n = 0; n < 2; ++n) { f32x4 v = acc[ai][bj][m][n] * rs; acc[ai][bj][m][n] = v; if (bj == 0) s += (v[0] * v[0] + v[1] * v[1]) + (v[2] * v[2] + v[3] * v[3]); }
                s = fq_sum(s);
                if (fq == 0) P[rt * 4 + wc] = s;
            }
        PG8_EPI_BAR();
#pragma unroll
        for (int ai = 0; ai < 2; ++ai)
#pragma unroll
            for (int m = 0; m < 4; ++m) {
                const int rt = ai * HALF + wr * 64 + m * 16 + fr, grow = u.pm * BM + rt;
                const f32x4 pp = *(const PG8_LAS f32x4*)(P + rt * 4);
                const float rk = rsqrtf(((pp[0] + pp[1]) + (pp[2] + pp[3])) * (1.0f / 192.0f) + RMS_EPS);
                const size_t bh_t = (size_t)((grow >> 11) * 8 + h) * 2048 + (grow & 2047);
                bf16_t* kd = KH + bh_t * 192; bf16_t* vd = VH + bh_t * 128;
                const int c = wc * 32 + 8 * fq;
                {
                    const f32x4 g0 = *(const f32x4*)(gk + c), g1 = *(const f32x4*)(gk + c + 4);
                    const f32x4 v0 = acc[ai][0][m][0] * g0 * rk, v1 = acc[ai][0][m][1] * g1 * rk;
                    u32x4 w; w.x = cvt_pk_bf16(v0[0], v0[1]); w.y = cvt_pk_bf16(v0[2], v0[3]); w.z = cvt_pk_bf16(v1[0], v1[1]); w.w = cvt_pk_bf16(v1[2], v1[3]);
                    *(u32x4*)(kd + c) = w;
                }
                {
                    const f32x4 v0 = acc[ai][1][m][0], v1 = acc[ai][1][m][1];
                    u32x4 w; w.x = cvt_pk_bf16(v0[0], v0[1]); w.y = cvt_pk_bf16(v0[2], v0[3]); w.z = cvt_pk_bf16(v1[0], v1[1]); w.w = cvt_pk_bf16(v1[2], v1[3]);
                    *(u32x4*)(vd + c) = w;
                }
                {
                    const int i0 = e0 >> 1;
                    const f32x4 kp = *(const f32x4*)(KPE + (size_t)grow * 64 + e0);
                    const float c0 = CS[(size_t)grow * 32 + i0], c1 = CS[(size_t)grow * 32 + i0 + 1], s0 = SN[(size_t)grow * 32 + i0], s1 = SN[(size_t)grow * 32 + i0 + 1];
                    const float a0 = kp[0] * gk[128 + i0] * rk, b0 = kp[1] * gk[160 + i0] * rk, a1 = kp[2] * gk[128 + i0 + 1] * rk, b1 = kp[3] * gk[160 + i0 + 1] * rk;
                    typedef unsigned u32x2 __attribute__((ext_vector_type(2)));
                    u32x2 w; w.x = cvt_pk_bf16(a0 * c0 - b0 * s0, b0 * c0 + a0 * s0); w.y = cvt_pk_bf16(a1 * c1 - b1 * s1, b1 * c1 + a1 * s1);
                    *(u32x2*)(kd + 128 + e0) = w;
                }
            }
        PG8_EPI_BAR();
    }
};
struct EpiGLU {
    static constexpr bool PERM = true, AFTER_DRAIN = false, HAS_MID = false;
    const bf16_t* YSv; const float* bias; bf16_t* Y; int ldy; float* SSo;
    __device__ __forceinline__ void operator()(const f32x4 (&acc)[2][2][4][2], const Unit& u, int wr, int wc, int fr, int fq) const {
        const int row0 = u.pm * BM + wr * 64 + fr, col0 = u.pn * BM + wc * 32 + 8 * fq;
#pragma unroll
        for (int ai = 0; ai < 2; ++ai)
#pragma unroll
            for (int m = 0; m < 4; ++m) {
                const int row = row0 + ai * HALF + m * 16;
                float ssq = 0.f;
#pragma unroll
                for (int bj = 0; bj < 2; ++bj) {
                    const int col = col0 + bj * HALF;
                    const u32x4 yv = *(const u32x4*)(YSv + (size_t)row * 1024 + col);
                    const f32x4 b0 = *(const f32x4*)(bias + col), b1 = *(const f32x4*)(bias + col + 4);
                    float o[8];
#pragma unroll
                    for (int e = 0; e < 8; ++e) {
                        const float t = (e < 4 ? acc[ai][bj][m][0][e & 3] + b0[e & 3] : acc[ai][bj][m][1][e & 3] + b1[e & 3]);
                        const unsigned wv = yv[e >> 1]; const float y = __builtin_bit_cast(float, (e & 1) ? (wv & 0xffff0000u) : (wv << 16));
                        o[e] = y * __builtin_amdgcn_rcpf(1.0f + __builtin_amdgcn_exp2f(-1.4426950408889634f * t));
                        ssq += o[e] * o[e];
                    }
                    u32x4 w; w.x = cvt_pk_bf16(o[0], o[1]); w.y = cvt_pk_bf16(o[2], o[3]); w.z = cvt_pk_bf16(o[4], o[5]); w.w = cvt_pk_bf16(o[6], o[7]);
                    *(u32x4*)(Y + (size_t)row * ldy + col) = w;
                }
                ssq = fq_sum(ssq);
                if (fq == 0) atomicAdd(SSo + row, ssq);
            }
    }
};
struct EpiWout {
    static constexpr bool PERM = true, AFTER_DRAIN = false, HAS_MID = true;
    const float* SSs; const float* SSa; float* RSio; bf16_t* xb; float* SSo; int ld;
    __device__ __forceinline__ void mid(f32x4 (&acc)[2][2][4][2], const Unit& u, int t, int wr, int wc, int fr, int fq) const {
        if (t != 16) return;
        int rz = u.pm * BM + wr * 64 + fr; asm volatile("" : "+v"(rz));
        const unsigned boff = (unsigned)rz * 4u;
#pragma unroll
        for (int ai = 0; ai < 2; ++ai)
#pragma unroll
            for (int m = 0; m < 4; ++m) {
                const unsigned o = boff + (unsigned)(ai * HALF + m * 16) * 4u;
                const float ratio = rstd_of(*(const float*)((const char*)SSs + o), 1.0f / 1024.0f) / rstd_of(*(const float*)((const char*)SSa + o), 1.0f / 1024.0f);
#pragma unroll
                for (int bj = 0; bj < 2; ++bj)
#pragma unroll
                    for (int n = 0; n < 2; ++n) acc[ai][bj][m][n] *= ratio;
            }
    }
    __device__ __forceinline__ void operator()(const f32x4 (&acc)[2][2][4][2], const Unit& u, int wr, int wc, int fr, int fq) const {
        const int row0 = u.pm * BM + wr * 64 + fr, col0 = u.pn * BM + wc * 32 + 8 * fq;
#pragma unroll
        for (int ai = 0; ai < 2; ++ai)
#pragma unroll
            for (int m = 0; m < 4; ++m) {
                const int row = row0 + ai * HALF + m * 16;
                const float ra = rstd_of(SSa[row], 1.0f / 1024.0f);
                float ssq = 0.f;
#pragma unroll
                for (int bj = 0; bj < 2; ++bj) {
                    const size_t off = (size_t)row * ld + col0 + bj * HALF;
                    const f32x4 b0 = *(const f32x4*)(RSio + off), b1 = *(const f32x4*)(RSio + off + 4);
                    const f32x4 v0 = b0 + acc[ai][bj][m][0] * ra, v1 = b1 + acc[ai][bj][m][1] * ra;
                    *(f32x4*)(RSio + off) = v0; *(f32x4*)(RSio + off + 4) = v1;
                    ssq += (v0[0] * v0[0] + v0[1] * v0[1]) + (v0[2] * v0[2] + v0[3] * v0[3]) + (v1[0] * v1[0] + v1[1] * v1[1]) + (v1[2] * v1[2] + v1[3] * v1[3]);
                    u32x4 w; w.x = cvt_pk_bf16(v0[0], v0[1]); w.y = cvt_pk_bf16(v0[2], v0[3]); w.z = cvt_pk_bf16(v1[0], v1[1]); w.w = cvt_pk_bf16(v1[2], v1[3]);
                    *(u32x4*)(xb + off) = w;
                }
                ssq = fq_sum(ssq);
                if (fq == 0) atomicAdd(SSo + row, ssq);
            }
    }
};
template <class Epi, class Sched, bool ALIGN_EPI = false, bool SP2 = false>
__device__ __forceinline__ void gemm_phase(PG8_LAS unsigned char* lds, const Gemm g, const Sched& S, const Epi& E) {
    const int tid = threadIdx.x, wid = __builtin_amdgcn_readfirstlane(tid >> 6), lane = tid & 63, wr = wid >> 2, wc = wid & 3, fr = lane & 15, fq = lane >> 4;
    const int K = g.K, nt = K / BK;
    unsigned voffA[2], voffB[2];
#pragma unroll
    for (int i = 0; i < 2; ++i) { int R, C; stage_rc(tid * 16 + i * 8192, R, C); const int Rb = Epi::PERM ? ((R & ~31) + perm32(R & 31)) : R;
        voffA[i] = (unsigned)(R * K + C) * 2u; voffB[i] = (unsigned)(Rb * K + C) * 2u; }
    const size_t kstep = (size_t)(BK * 2);
    const size_t hstep = (size_t)HALF * K * 2;
    const size_t tstep = 2 * hstep;
    const unsigned ldsw = (unsigned)wid * 1024u;
    const int aoff = lds_byte(wr * 64 + fr, fq * 8), boff = lds_byte(wc * 32 + fr, fq * 8);
#define PG8_SA(b, h) (((b) * 2 + (h)) * HTB)
#define PG8_SB(b, h) ((4 + (b) * 2 + (h)) * HTB)
#define PG8_STAGE(bufoff, gbase, voff) do { _Pragma("unroll") for (int _i = 0; _i < 2; ++_i) \
        __builtin_amdgcn_global_load_lds((const unsigned*)((const char*)(gbase) + (voff)[_i]), (PG8_LAS unsigned*)(lds + (bufoff) + ldsw + _i * 8192), 16, 0, 0); } while (0)
#define PG8_LDA(dst, b, h) do { _Pragma("unroll") for (int m = 0; m < 4; ++m) _Pragma("unroll") for (int k = 0; k < 2; ++k) dst[m][k] = *(const PG8_LAS bf16x8*)(lds + PG8_SA(b, h) + aoff + m * 2048 + k * 1024); } while (0)
#define PG8_LDB(dst, b, h) do { _Pragma("unroll") for (int n = 0; n < 2; ++n) _Pragma("unroll") for (int k = 0; k < 2; ++k) dst[n][k] = *(const PG8_LAS bf16x8*)(lds + PG8_SB(b, h) + boff + n * 2048 + k * 1024); } while (0)
#define PG8_MMA(ai, bj, At, Bt) do { __builtin_amdgcn_s_setprio(1); _Pragma("unroll") for (int m = 0; m < 4; ++m) _Pragma("unroll") for (int n = 0; n < 2; ++n) _Pragma("unroll") for (int k = 0; k < 2; ++k) \
        acc[ai][bj][m][n] = __builtin_amdgcn_mfma_f32_16x16x32_bf16(Bt[n][k], At[m][k], acc[ai][bj][m][n], 0, 0, 0); __builtin_amdgcn_s_setprio(0); } while (0)
#define PG8_WAIT_V(n) asm volatile("s_waitcnt vmcnt(" #n ")" ::: "memory")
#define PG8_WAIT_L(n) asm volatile("s_waitcnt lgkmcnt(" #n ")" ::: "memory")
#define PG8_BAR __builtin_amdgcn_s_barrier()
#define PG8_SCHED __builtin_amdgcn_sched_barrier(0)
    Unit cur, nxt; int ui = 0;
    if (!S.next(0, cur)) return;
    f32x4 acc[2][2][4][2];
#pragma unroll
    for (int a = 0; a < 2; ++a)
#pragma unroll
        for (int b = 0; b < 2; ++b)
#pragma unroll
            for (int m = 0; m < 4; ++m)
#pragma unroll
                for (int n = 0; n < 2; ++n) acc[a][b][m][n] = (f32x4){0.f, 0.f, 0.f, 0.f};
    bf16x8 At[4][2], B0[2][2], B1[2][2];
    const char* cA = (const char*)g.A + (size_t)cur.pm * tstep; const char* cB = (const char*)g.Bt + (size_t)cur.pn * tstep;
    S.a_ready(cur);
    if constexpr (SP2) {
        PG8_STAGE(PG8_SB(0, 0), cB, voffB); PG8_STAGE(PG8_SB(0, 1), cB + hstep, voffB); PG8_STAGE(PG8_SA(0, 0), cA, voffA); PG8_STAGE(PG8_SA(0, 1), cA + hstep, voffA);
        if (wr == 1) PG8_BAR;
        PG8_WAIT_V(2); PG8_BAR;
        PG8_STAGE(PG8_SB(1, 0), cB + kstep, voffB); PG8_STAGE(PG8_SA(1, 0), cA + kstep, voffA); PG8_STAGE(PG8_SB(1, 1), cB + hstep + kstep, voffB);
        PG8_WAIT_V(6); PG8_BAR;
    } else {
        PG8_STAGE(PG8_SB(0, 0), cB, voffB); PG8_STAGE(PG8_SA(0, 0), cA, voffA); PG8_STAGE(PG8_SB(0, 1), cB + hstep, voffB); PG8_STAGE(PG8_SA(0, 1), cA + hstep, voffA);
        if (wr == 1) PG8_BAR;
        PG8_WAIT_V(4); PG8_BAR;
        PG8_STAGE(PG8_SB(1, 0), cB + kstep, voffB); PG8_STAGE(PG8_SA(1, 0), cA + kstep, voffA); PG8_STAGE(PG8_SB(1, 1), cB + hstep + kstep, voffB);
        PG8_WAIT_V(6); PG8_BAR;
    }
    for (;;) {
        const bool has_next = S.next(ui + 1, nxt);
        const char* nA = has_next ? (const char*)g.A + (size_t)nxt.pm * tstep : cA; const char* nB = has_next ? (const char*)g.Bt + (size_t)nxt.pn * tstep : cB;
        for (int t = 0; t < nt; t += 2) {
            if constexpr (Epi::HAS_MID) E.mid(acc, cur, t, wr, wc, fr, fq);
            const bool last = (t == nt - 2);
            const char* a1 = cA + (size_t)(t + 1) * kstep;
            const char* a2 = last ? nA : cA + (size_t)(t + 2) * kstep; const char* b2 = last ? nB : cB + (size_t)(t + 2) * kstep;
            const char* a3 = a2 + kstep; const char* b3 = b2 + kstep;
            if (last && has_next) S.a_ready(nxt);
            if constexpr (SP2) {
            PG8_LDB(B0, 0, 0); PG8_LDB(B1, 0, 1); PG8_SCHED; PG8_LDA(At, 0, 0); PG8_STAGE(PG8_SA(1, 1), a1 + hstep, voffA);
            PG8_WAIT_V(8); PG8_WAIT_L(0); PG8_BAR; PG8_MMA(0, 0, At, B0); PG8_MMA(0, 1, At, B1); PG8_BAR; PG8_SCHED;
            PG8_LDA(At, 0, 1); PG8_STAGE(PG8_SB(0, 0), b2, voffB); PG8_STAGE(PG8_SB(0, 1), b2 + hstep, voffB); PG8_STAGE(PG8_SA(0, 0), a2, voffA);
            PG8_WAIT_V(8); PG8_WAIT_L(0); PG8_BAR; PG8_MMA(1, 0, At, B0); PG8_MMA(1, 1, At, B1); PG8_BAR; PG8_SCHED;
            PG8_LDB(B0, 1, 0); PG8_LDB(B1, 1, 1); PG8_SCHED; PG8_LDA(At, 1, 0); PG8_STAGE(PG8_SA(0, 1), a2 + hstep, voffA);
            PG8_WAIT_V(8); PG8_WAIT_L(0); PG8_BAR; PG8_MMA(0, 0, At, B0); PG8_MMA(0, 1, At, B1); PG8_BAR; PG8_SCHED;
            PG8_LDA(At, 1, 1); PG8_STAGE(PG8_SB(1, 0), b3, voffB); PG8_STAGE(PG8_SB(1, 1), b3 + hstep, voffB); PG8_STAGE(PG8_SA(1, 0), a3, voffA);
            PG8_WAIT_V(8); PG8_WAIT_L(0); PG8_BAR; PG8_MMA(1, 0, At, B0); PG8_MMA(1, 1, At, B1); PG8_BAR; PG8_SCHED;
            } else {
            PG8_LDB(B0, 0, 0); PG8_SCHED; PG8_LDA(At, 0, 0); PG8_STAGE(PG8_SA(1, 1), a1 + hstep, voffA);
            PG8_WAIT_L(8); PG8_BAR; PG8_WAIT_L(0); PG8_MMA(0, 0, At, B0); PG8_BAR; PG8_SCHED;
            PG8_LDB(B1, 0, 1); PG8_STAGE(PG8_SB(0, 0), b2, voffB);
            PG8_BAR; PG8_WAIT_L(0); PG8_MMA(0, 1, At, B1); PG8_BAR;
            PG8_LDA(At, 0, 1); PG8_STAGE(PG8_SA(0, 0), a2, voffA);
            PG8_BAR; PG8_WAIT_L(0); PG8_MMA(1, 0, At, B0); PG8_BAR; PG8_SCHED;
            PG8_STAGE(PG8_SB(0, 1), b2 + hstep, voffB);
            PG8_WAIT_V(6); PG8_BAR; PG8_MMA(1, 1, At, B1); PG8_BAR;
            PG8_LDB(B0, 1, 0); PG8_SCHED; PG8_LDA(At, 1, 0); PG8_STAGE(PG8_SA(0, 1), a2 + hstep, voffA);
            PG8_WAIT_L(8); PG8_BAR; PG8_WAIT_L(0); PG8_MMA(0, 0, At, B0); PG8_BAR; PG8_SCHED;
            PG8_LDB(B1, 1, 1); PG8_STAGE(PG8_SB(1, 0), b3, voffB);
            PG8_BAR; PG8_WAIT_L(0); PG8_MMA(0, 1, At, B1); PG8_BAR;
            PG8_LDA(At, 1, 1); PG8_STAGE(PG8_SA(1, 0), a3, voffA);
            PG8_BAR; PG8_WAIT_L(0); PG8_MMA(1, 0, At, B0); PG8_BAR; PG8_SCHED;
            PG8_STAGE(PG8_SB(1, 1), b3 + hstep, voffB);
            PG8_WAIT_V(6); PG8_BAR; PG8_MMA(1, 1, At, B1); PG8_BAR;
            }
        }
        if constexpr (ALIGN_EPI) { if (wr == 0) PG8_BAR; }
        if constexpr (!Epi::AFTER_DRAIN) { E(acc, cur, wr, wc, fr, fq); S.done(cur); }
        if (!has_next) break;
#pragma unroll
        for (int a = 0; a < 2; ++a)
#pragma unroll
            for (int b = 0; b < 2; ++b)
#pragma unroll
                for (int m = 0; m < 4; ++m)
#pragma unroll
                    for (int n = 0; n < 2; ++n) acc[a][b][m][n] = (f32x4){0.f, 0.f, 0.f, 0.f};
        cur = nxt; cA = nA; cB = nB; ++ui;
        if constexpr (ALIGN_EPI) { if (wr == 1) PG8_BAR; }
    }
    PG8_WAIT_V(0);
    if constexpr (!ALIGN_EPI) { if (wr == 0) PG8_BAR; }
    PG8_BAR;
    if constexpr (Epi::AFTER_DRAIN) { E.fused(acc, cur, wr, wc, fr, fq, lds, wid, lane); S.done(cur); }
#undef PG8_SA
#undef PG8_SB
#undef PG8_STAGE
#undef PG8_LDA
#undef PG8_LDB
#undef PG8_MMA
#undef PG8_WAIT_V
#undef PG8_WAIT_L
#undef PG8_BAR
#undef PG8_SCHED
}
}

constexpr int NWAVES = 8;
constexpr int DM = 2048, NB = 4, SEQ = 2048, MT = NB * SEQ  , DFF = 5632, DIN = 1856, DINP = 2048  , SSMW = 1024, NG = 64, NS = 64, GC = 16;
constexpr int NH = 8, QKH = 192, VHD = 128, ATTW = 1024, QL = 512, KVL = 256, QUPP = NH * 256  , KVUP = NH * 256;
constexpr float EPS = 1e-6f;
constexpr float QSCALE = 0.07216878364870322f * 1.4426950408889634f;
constexpr size_t MiB = 1u << 20;
constexpr size_t WS_CTL = 0, CTL_ZERO_BYTES = 64 * 1024 + 8 * 32768;
constexpr size_t WS_SS = 64 * 1024;
constexpr size_t WS_CS = 2 * MiB, WS_SN = 3 * MiB;
constexpr size_t WS_KPE = 4 * MiB;
constexpr size_t WS_TAB = 6 * MiB;
constexpr size_t WS_KT = 8 * MiB, WS_PF = 10 * MiB, WS_RF = 26 * MiB;
constexpr size_t WS_W1GU = 42 * MiB, WS_W1D = 86 * MiB, WS_W2GU = 108 * MiB, WS_W2D = 152 * MiB;
constexpr size_t WS_WIN = 174 * MiB, WS_WOUT = 182 * MiB, WS_WGLU = 190 * MiB, WS_WQ = 192 * MiB, WS_WKV = 194 * MiB;
constexpr size_t WS_XB = 196 * MiB;
constexpr size_t WS_H = 228 * MiB;
constexpr size_t WS_END = 316 * MiB;
constexpr size_t WS_QH = WS_W1GU, WS_KH = WS_W1GU + 24 * MiB, WS_VH = WS_W1GU + 48 * MiB;
constexpr size_t WS_Y = WS_H;
constexpr size_t WS_U = WS_H, WS_QLAT = WS_H + 16 * MiB, WS_KVLAT = WS_H + 24 * MiB;
constexpr size_t WS_YS = WS_H + 32 * MiB;
enum { SS1 = 0, SS2, SSQ, SSKV, SSS, SSA, SS3, SS4, NSS };
constexpr int CW_BAR = 1024;
constexpr int RING_OFF = 0, RING_BYTES = 131072;
constexpr int LDSCTL_OFF = RING_BYTES, MISC_OFF = LDSCTL_OFF + 320;
constexpr int LDS_BYTES = 147456;

#define GAS __attribute__((address_space(1)))
#define LAS __attribute__((address_space(3)))
typedef unsigned short bf16;
typedef unsigned v4u __attribute__((ext_vector_type(4)));
typedef unsigned v2u __attribute__((ext_vector_type(2)));
typedef float f32x4 __attribute__((ext_vector_type(4)));
typedef float f32x16 __attribute__((ext_vector_type(16)));
typedef short bf16x8 __attribute__((ext_vector_type(8)));
typedef GAS unsigned gu32;
#define RLX_AGENT __ATOMIC_RELAXED, __HIP_MEMORY_SCOPE_AGENT
#define LDS_WAIT() asm volatile("s_waitcnt lgkmcnt(0)" ::: "memory")
#define VM_WAIT() asm volatile("s_waitcnt vmcnt(0)" ::: "memory")
__device__ __forceinline__ unsigned f2bf(float f) { unsigned u = __builtin_bit_cast(unsigned, f); return (u + 0x7fffu + ((u >> 16) & 1u)) >> 16; }
__device__ __forceinline__ unsigned pk2(float lo, float hi) { return f2bf(lo) | (f2bf(hi) << 16); }
__device__ __forceinline__ float bf2f(unsigned short b) { return __builtin_bit_cast(float, (unsigned)b << 16); }
__device__ __forceinline__ float wave_sum(float v) {
#pragma unroll
    for (int o = 1; o < 64; o <<= 1) v += __shfl_xor(v, o);
    return v;
}
#define XB_TMO      128
#define XB_XCNT(j)  (256  + 64 * (j))
#define XB_XSUB(j)  (1280 + 64 * (j))
#define XB_XGEN(j)  (2304 + 64 * (j))
#define XB_TOP      3328
#define XB_TOPGEN   3392
#define XCD_BAR_WORDS 3456
#define XB_SPIN_CAP (1u << 18)

__device__ __forceinline__ unsigned xb_ld(unsigned* p)              { return __hip_atomic_load(p, __ATOMIC_RELAXED, __HIP_MEMORY_SCOPE_AGENT); }
__device__ __forceinline__ unsigned xb_add(unsigned* p, unsigned v) { return __hip_atomic_fetch_add(p, v, __ATOMIC_RELAXED, __HIP_MEMORY_SCOPE_AGENT); }
__device__ __forceinline__ unsigned xb_xcc_id() { return (unsigned)__builtin_amdgcn_s_getreg((3 << 11) | 20) & 0xFu; }
#define XB_SPIN(cond, bar) do { unsigned _sp = 0; while (cond) { __builtin_amdgcn_s_sleep(1); \
    if ((++_sp & 255u) == 0u) { if (xb_ld(&(bar)[XB_TMO])) break; if (_sp > XB_SPIN_CAP) { atomicAdd(&(bar)[XB_TMO], 1u); break; } } } } while (0)

struct XcdBarrier {
    unsigned* bar; unsigned x;
    volatile LAS unsigned* st;
};

__device__ __forceinline__ XcdBarrier xcd_barrier_post(unsigned* bar, volatile LAS unsigned* st) {
    XcdBarrier b; b.bar = bar; b.x = xb_xcc_id(); b.st = st;
    if (threadIdx.x == 0) (void)xb_add(&bar[XB_XCNT(b.x)], 1u);
    return b;
}
__device__ __forceinline__ void xcd_barrier_complete(unsigned* bar, unsigned x, unsigned& nloc, unsigned& nx) {
    const unsigned G = gridDim.x * gridDim.y * gridDim.z;
    unsigned sum, cnt, mine, sp = 0u;
    for (;;) {
        sum = 0u; cnt = 0u; mine = 0u;
#pragma unroll
        for (unsigned j = 0; j < 16; ++j) { const unsigned c = xb_ld(&bar[XB_XCNT(j)]); sum += c; cnt += (c > 0u) ? 1u : 0u; mine = (j == x) ? c : mine; }
        if (sum == G) break;
        __builtin_amdgcn_s_sleep(1);
        if ((++sp & 255u) == 0u) { if (xb_ld(&bar[XB_TMO])) break; if (sp > XB_SPIN_CAP) { atomicAdd(&bar[XB_TMO], 1u); break; } }
    }
    nloc = mine > 0u ? mine : 1u; nx = cnt > 0u ? cnt : 1u;
}

__device__ __forceinline__ void xcd_barrier(const XcdBarrier& b) {
    asm volatile("s_waitcnt vmcnt(0)" ::: "memory");
    __syncthreads();
    if (threadIdx.x == 0) {
        unsigned* bar = b.bar;
        __builtin_amdgcn_s_waitcnt(0);
        unsigned nloc = b.st[0], nx = b.st[1];
        if (nloc == 0u) { xcd_barrier_complete(bar, b.x, nloc, nx); b.st[0] = nloc; b.st[1] = nx; }
        const unsigned old = xb_add(&bar[XB_XSUB(b.x)], 1u);
        const unsigned gen = old / nloc;
        if (old + 1u == (gen + 1u) * nloc) {
            __builtin_amdgcn_fence(__ATOMIC_RELEASE, "agent");
            asm volatile("s_waitcnt vmcnt(0)" ::: "memory");
            const unsigned og = xb_add(&bar[XB_TOP], 1u);
            const unsigned tg = og / nx;
            if (og + 1u == (tg + 1u) * nx) xb_add(&bar[XB_TOPGEN], 1u);
            else XB_SPIN(xb_ld(&bar[XB_TOPGEN]) == tg, bar);
            __builtin_amdgcn_fence(__ATOMIC_ACQUIRE, "agent");
            xb_add(&bar[XB_XGEN(b.x)], 1u);
            asm volatile("s_waitcnt vmcnt(0)" ::: "memory");
        } else {
            XB_SPIN(xb_ld(&bar[XB_XGEN(b.x)]) == gen, bar);
            __builtin_amdgcn_fence(__ATOMIC_ACQUIRE, "agent");
            asm volatile("s_waitcnt vmcnt(0)" ::: "memory");
        }
    }
    __syncthreads();
}

struct Args { const float* in[32]; float* out; unsigned char* ws; int ph_lo, ph_hi; };
struct Frame {
    LAS unsigned char* lds;
    volatile LAS unsigned* MISC;
    gu32* ctl;
    int tid, lane, wave;
    int vcu, G;
};


__device__ __forceinline__ void s5_lane_params(const Args& a, int g, int n, float& lr, float& li, float& fr, float& fi) {
    const float dt = expf(a.in[8][g]);
    const float ar = a.in[9][g * NS + n], ai = a.in[10][g * NS + n];
    const float mag = expf(ar * dt), ang = ai * dt;
    lr = mag * cosf(ang); li = mag * sinf(ang);
    const float den = ar * ar + ai * ai;
    fr = ((lr - 1.f) * ar + li * ai) / den; fi = (li * ar - (lr - 1.f) * ai) / den;
}
__device__ __forceinline__ void s5_tab_kp_item(const Args& a, unsigned char* ws, LAS float* scr, int item, int lane) {
    const int g = item >> 6, k = item & 63, n = lane;
    float lr, li, fr, fi; s5_lane_params(a, g, n, lr, li, fr, fi);
    float pr = 1.f, pi = 0.f;
    for (int q = 0; q < k; ++q) { const float t = pr * lr - pi * li; pi = pr * li + pi * lr; pr = t; }
    const float* bre = a.in[11] + (size_t)(g * NS + n) * GC; const float* bim = a.in[12] + (size_t)(g * NS + n) * GC;
#pragma unroll
    for (int ci = 0; ci < 16; ++ci) { const float br = bre[ci], bi = bim[ci]; const float Br = fr * br - fi * bi, Bi = fr * bi + fi * br;
        scr[n * 16 + ci] = pr * Br - pi * Bi; scr[1024 + n * 16 + ci] = pr * Bi + pi * Br; }
    LDS_WAIT(); asm volatile("" ::: "memory");
    {
        const int ci = lane & 15; bf16* KT = (bf16*)(ws + WS_KT);
#pragma unroll
        for (int jj = 0; jj < 4; ++jj) { const int co = (lane >> 4) + 4 * jj; const float* cr = a.in[13] + (size_t)(g * GC + co) * NS; const float* cim = a.in[14] + (size_t)(g * GC + co) * NS;
            float s = 0.f;
            for (int m = 0; m < 64; ++m) s += cr[m] * scr[m * 16 + ci] - cim[m] * scr[1024 + m * 16 + ci];
            KT[((size_t)(g * 64 + k) * 16 + co) * 16 + ci] = (bf16)f2bf(s); }
    }
    {
        const int j = 63 - k, h = lane >> 5;
#pragma unroll
        for (int rb = 0; rb < 4; ++rb) { const int row = rb * 32 + (lane & 31), n2 = row & 63, isim = row >> 6; const LAS float* s = scr + isim * 1024 + n2 * 16 + 8 * h;
            v4u o; o.x = pk2(s[0], s[1]); o.y = pk2(s[2], s[3]); o.z = pk2(s[4], s[5]); o.w = pk2(s[6], s[7]);
            *(GAS v4u*)(ws + WS_PF + ((((size_t)(g * 4 + rb) * 64 + j) * 64 + lane) * 16)) = o; }
    }
    LDS_WAIT(); asm volatile("" ::: "memory");
}
__device__ __forceinline__ void s5_tab_r_item(const Args& a, unsigned char* ws, LAS float* scr, int item, int lane) {
    const int g = item >> 5, rb = item & 31, n = lane;
    float lr, li, fr, fi; s5_lane_params(a, g, n, lr, li, fr, fi);
    float pr = lr, pi = li;
    for (int q = 0; q < 2 * rb; ++q) { const float t = pr * lr - pi * li; pi = pr * li + pi * lr; pr = t; }
    const float p2r = pr * lr - pi * li, p2i = pr * li + pi * lr;
#pragma unroll
    for (int co = 0; co < 16; ++co) { const float cr = a.in[13][(size_t)(g * GC + co) * NS + n], ci = a.in[14][(size_t)(g * GC + co) * NS + n];
        scr[(0 * 16 + co) * 64 + n] = cr * pr - ci * pi;   scr[2048 + (0 * 16 + co) * 64 + n] = -(cr * pi + ci * pr);
        scr[(1 * 16 + co) * 64 + n] = cr * p2r - ci * p2i; scr[2048 + (1 * 16 + co) * 64 + n] = -(cr * p2i + ci * p2r); }
    LDS_WAIT(); asm volatile("" ::: "memory");
    const int i2 = (lane & 31) >> 4, co = lane & 15, h = lane >> 5;
#pragma unroll
    for (int ks = 0; ks < 8; ++ks) { const LAS float* s = scr + (ks >> 2) * 2048 + (i2 * 16 + co) * 64 + (ks & 3) * 16 + 8 * h;
        v4u o; o.x = pk2(s[0], s[1]); o.y = pk2(s[2], s[3]); o.z = pk2(s[4], s[5]); o.w = pk2(s[6], s[7]);
        *(GAS v4u*)(ws + WS_RF + ((((size_t)(g * 32 + rb) * 8 + ks) * 64 + lane) * 16)) = o; }
    LDS_WAIT(); asm volatile("" ::: "memory");
}

constexpr int S5_US = 0, S5_KT = 65536, S5_ES = 98304, S5_SP = 114688, S5_LAM = 122880;
#define S5_BAR() do { asm volatile("s_waitcnt vmcnt(0) lgkmcnt(0)" ::: "memory"); __builtin_amdgcn_s_barrier(); asm volatile("" ::: "memory"); } while (0)
__device__ __forceinline__ void s5_item(Frame& F, const Args& a, int b, int g) {
    unsigned char* ws = a.ws;
    LAS unsigned char* L = F.lds + RING_OFF;
    const int tid = F.tid, lane = F.lane, w = F.wave, r32 = lane & 31, hi = lane >> 5;
    {
        const bf16* U = (const bf16*)(ws + WS_U) + ((size_t)b * SEQ) * SSMW + g * GC;
#pragma unroll
        for (int i = 0; i < 8; ++i) { const int p = tid + 512 * i, t = p >> 1, hf = p & 1;
            const v4u v = *(const GAS v4u*)(U + (size_t)t * SSMW + 8 * hf);
            *(LAS v4u*)(L + S5_US + (((t & 63) * 32 + (t >> 6)) * 16 + 8 * hf) * 2) = v; }
        const GAS v4u* kt = (const GAS v4u*)(ws + WS_KT + (size_t)g * 32768);
#pragma unroll
        for (int i = 0; i < 4; ++i) *(LAS v4u*)(L + S5_KT + (tid + 512 * i) * 16) = kt[tid + 512 * i];
        if (w == 0) { float lr, li, fr, fi; s5_lane_params(a, g, lane, lr, li, fr, fi);
            float pr = lr, pi = li;
#pragma unroll
            for (int q = 0; q < 6; ++q) { const float t = pr * pr - pi * pi; pi = 2.f * pr * pi; pr = t; }
            ((LAS float*)(L + S5_LAM))[lane] = pr; ((LAS float*)(L + S5_LAM))[64 + lane] = pi; }
    }
    S5_BAR();
    if (w < 4) {
        f32x16 acc = {};
        const GAS bf16x8* pf = (const GAS bf16x8*)(ws + WS_PF) + ((size_t)(g * 4 + w) * 64) * 64 + lane;
        const LAS unsigned char* ub = L + S5_US + r32 * 32 + hi * 16;
#pragma unroll 8
        for (int j = 0; j < 64; ++j) { const bf16x8 A = pf[(size_t)j * 64]; const bf16x8 B = *(const LAS bf16x8*)(ub + j * 1024);
            acc = __builtin_amdgcn_mfma_f32_32x32x16_bf16(A, B, acc, 0, 0, 0); }
        LAS float* Es = (LAS float*)(L + S5_ES);
#pragma unroll
        for (int r = 0; r < 16; ++r) Es[(w * 32 + (r & 3) + 8 * (r >> 2) + 4 * hi) * 32 + r32] = acc[r];
    }
    S5_BAR();
    if (w == 0) {
        const LAS float* Es = (const LAS float*)(L + S5_ES); const float l64r = ((LAS float*)(L + S5_LAM))[lane], l64i = ((LAS float*)(L + S5_LAM))[64 + lane];
        LAS bf16* Sp = (LAS bf16*)(L + S5_SP);
        float sr = 0.f, si = 0.f; const int n = lane;
        for (int c = 0; c < 32; ++c) {
            Sp[(((n >> 4) * 32 + c) * 16 + (n & 15))] = (bf16)f2bf(sr);
            Sp[((((64 + n) >> 4) * 32 + c) * 16 + (n & 15))] = (bf16)f2bf(si);
            const float er = Es[n * 32 + c], ei = Es[(64 + n) * 32 + c];
            const float t = l64r * sr - l64i * si + er; si = l64r * si + l64i * sr + ei; sr = t;
        }
    }
    S5_BAR();
    {
        const float* Dg = a.in[15] + g * GC;
        float dv[2][4];
#pragma unroll
        for (int q = 0; q < 2; ++q)
#pragma unroll
            for (int e = 0; e < 4; ++e) dv[q][e] = Dg[e + 8 * q + 4 * hi];
        bf16* YS = (bf16*)(ws + WS_YS) + ((size_t)b * SEQ) * SSMW + g * GC;
        const LAS unsigned char* ub = L + S5_US + r32 * 32 + hi * 16;
        const LAS unsigned char* sb = L + S5_SP + r32 * 32 + hi * 16;
#pragma unroll 1
        for (int q4 = 0; q4 < 4; ++q4) {
            const int rb = (q4 == 0) ? w : (q4 == 1) ? 15 - w : (q4 == 2) ? 16 + w : 31 - w;
            f32x16 acc = {};
            const GAS bf16x8* rf = (const GAS bf16x8*)(ws + WS_RF) + ((size_t)(g * 32 + rb) * 8) * 64 + lane;
#pragma unroll
            for (int ks = 0; ks < 8; ++ks) { const bf16x8 A = rf[(size_t)ks * 64]; const bf16x8 B = *(const LAS bf16x8*)(sb + ks * 1024);
                acc = __builtin_amdgcn_mfma_f32_32x32x16_bf16(A, B, acc, 0, 0, 0); }
            const int irow = 2 * rb + (r32 >> 4), co = r32 & 15;
            const int nj = 2 * rb + 2;
#pragma unroll 4
            for (int j = 0; j < nj; ++j) { const int kidx = irow - j; const int kk = kidx < 0 ? 0 : kidx;
                bf16x8 A = *(const LAS bf16x8*)(L + S5_KT + (kk * 16 + co) * 32 + hi * 16);
                if (kidx < 0) A = (bf16x8){0, 0, 0, 0, 0, 0, 0, 0};
                const bf16x8 B = *(const LAS bf16x8*)(ub + j * 1024);
                acc = __builtin_amdgcn_mfma_f32_32x32x16_bf16(A, B, acc, 0, 0, 0); }
#pragma unroll
            for (int ib = 0; ib < 2; ++ib)
#pragma unroll
                for (int q = 0; q < 2; ++q) { const int i = 2 * rb + ib, co0 = 8 * q + 4 * hi;
                    const LAS bf16* up = (const LAS bf16*)(L + S5_US) + (i * 32 + r32) * 16 + co0;
                    float y[4];
#pragma unroll
                    for (int e = 0; e < 4; ++e) { float v = acc[ib * 8 + q * 4 + e] + dv[q][e] * bf2f(up[e]);
                        const float inner = 0.7978845608028654f * (v + 0.044715f * v * v * v);
                        y[e] = v * __builtin_amdgcn_rcpf(1.0f + __builtin_amdgcn_exp2f(-2.0f * 1.4426950408889634f * inner)); }
                    v2u o; o.x = pk2(y[0], y[1]); o.y = pk2(y[2], y[3]);
                    *(GAS v2u*)(YS + (size_t)(64 * r32 + i) * SSMW + co0) = o; }
        }
    }
    S5_BAR();
}

namespace att {
constexpr int KS = 400, VS = 320;
constexpr int KBUF = 64 * KS, VBUF = 64 * VS;
constexpr int L_K = 0, L_V = 2 * KBUF, L_SCR = L_V + 2 * VBUF, L_QX = L_SCR + 8 * 256, L_END = L_QX + 8 * 4096;
static_assert(L_END <= RING_BYTES && 8 * 8192 <= L_SCR, "attention LDS map");
typedef short v4i16_t __attribute__((ext_vector_type(4)));
typedef short s16x4 __attribute__((ext_vector_type(4)));
__device__ __forceinline__ s16x4 vtr(const LAS unsigned char* p) { return __builtin_bit_cast(s16x4, __builtin_amdgcn_ds_read_tr16_b64_v4i16((LAS v4i16_t*)p)); }
__device__ __forceinline__ int crow(int r, int hi) { return (r & 3) + 8 * (r >> 2) + 4 * hi; }
__device__ __forceinline__ unsigned cvtpk(float lo, float hi) { unsigned r; asm volatile("v_cvt_pk_bf16_f32 %0, %1, %2" : "=v"(r) : "v"(lo), "v"(hi)); return r; }
template <int CTRL> __device__ __forceinline__ float dpp_add(float v) { return v + __builtin_bit_cast(float, __builtin_amdgcn_update_dpp(0, __builtin_bit_cast(int, v), CTRL, 0xF, 0xF, true)); }
__device__ __forceinline__ float row16_sum(float v) { v = dpp_add<0xB1>(v); v = dpp_add<0x4E>(v); v = dpp_add<0x141>(v); v = dpp_add<0x140>(v); return v; }
#define ATT_BAR() do { asm volatile("s_waitcnt vmcnt(0) lgkmcnt(0)" ::: "memory"); __builtin_amdgcn_s_barrier(); asm volatile("" ::: "memory"); } while (0)

__device__ __forceinline__ void attn_unit(Frame& F, const Args& a, int bh, int qb, float negC, float* SSAarr) {
    unsigned char* ws = a.ws;
    LAS unsigned char* L = F.lds + RING_OFF;
    int tid = F.tid; asm volatile("" : "+v"(tid));
    const int lane = tid & 63, w = F.wave, r32 = lane & 31, hi = lane >> 5;
    const int c0 = qb * 4, NT = c0 + 4, my_nt = c0 + (w >> 1) + 1;
    const unsigned char* Qg = ws + WS_QH + ((size_t)bh * SEQ + qb * 256 + 32 * w) * QKH * 2;
    const unsigned char* Kg = ws + WS_KH + (size_t)bh * SEQ * QKH * 2;
    const unsigned char* Vg = ws + WS_VH + (size_t)bh * SEQ * VHD * 2;
    const unsigned srow = (unsigned)tid >> 3, sch = ((unsigned)tid & 7u) * 16u;
    const unsigned kgo = srow * 384u + sch, vgo = srow * 256u + sch, kdo = srow * KS + sch, vdo = srow * VS + sch;
    v4u kst[3], vst[2];
#define ATT_LOADK(t) do { const unsigned char* kt_ = Kg + (size_t)(t) * 24576; _Pragma("unroll") for (int i = 0; i < 3; ++i) kst[i] = *(const GAS v4u*)(kt_ + (kgo + 128u * i)); } while (0)
#define ATT_LOADV(t) do { const unsigned char* vt_ = Vg + (size_t)(t) * 16384; _Pragma("unroll") for (int i = 0; i < 2; ++i) vst[i] = *(const GAS v4u*)(vt_ + (vgo + 128u * i)); } while (0)
#define ATT_WRITEK(buf) do { _Pragma("unroll") for (int i = 0; i < 3; ++i) *(LAS v4u*)(L + L_K + (buf) * KBUF + kdo + 128 * i) = kst[i]; } while (0)
#define ATT_WRITEV(buf) do { _Pragma("unroll") for (int i = 0; i < 2; ++i) *(LAS v4u*)(L + L_V + (buf) * VBUF + vdo + 128 * i) = vst[i]; } while (0)
    ATT_LOADK(0); ATT_LOADV(0);
    bf16x8 qf[8];
    LAS unsigned char* qx = L + L_QX + w * 4096 + lane * 16;
#pragma unroll
    for (int s = 0; s < 12; ++s) { const bf16x8 v = *(const GAS bf16x8*)(Qg + ((unsigned)(r32 * QKH + hi * 8) * 2u + 32u * s));
        if (s < 8) qf[s] = v; else *(LAS bf16x8*)(qx + (s - 8) * 1024) = v; }
    f32x16 o[4];
#pragma unroll
    for (int d = 0; d < 4; ++d) o[d] = (f32x16){};
    float lsum = 0.f;
    ATT_WRITEK(0); ATT_WRITEV(0);
    ATT_BAR();
    const int koff = r32 * KS + hi * 16;
    const int voff = (4 * hi + ((lane & 15) >> 2)) * VS + (((lane >> 4) & 1) * 16 + (lane & 3) * 4) * 2;
    for (int t = 0; t < NT; ++t) {
        const int buf = t & 1;
        const bool more = (t + 1 < NT);
        if (more) { ATT_LOADK(t + 1); ATT_LOADV(t + 1); }
        if (t < my_nt) {
            const LAS unsigned char* Kb = L + L_K + buf * KBUF + koff;
            const LAS unsigned char* Vb = L + L_V + buf * VBUF + voff;
#pragma unroll 1
            for (int kb = 0; kb < 2; ++kb) {
                f32x16 p;
#pragma unroll
                for (int r = 0; r < 16; ++r) p[r] = negC;
#pragma unroll
                for (int s = 0; s < 12; ++s) {
                    const bf16x8 kf = *(const LAS bf16x8*)(Kb + kb * 32 * KS + s * 32);
                    const bf16x8 qv = (s < 8) ? qf[s < 8 ? s : 0] : *(const LAS bf16x8*)(qx + (s - 8) * 1024);
                    p = __builtin_amdgcn_mfma_f32_32x32x16_bf16(kf, qv, p, 0, 0, 0);
                    if (s == 3 || s == 7) __builtin_amdgcn_sched_barrier(0);
                }
                __builtin_amdgcn_sched_barrier(0);
                float sacc = 0.f;
#pragma unroll
                for (int r = 0; r < 16; ++r) { p[r] = __builtin_amdgcn_exp2f(p[r]); sacc += p[r]; }
                lsum += sacc;
                v4u pa[2];
#pragma unroll
                for (int s2 = 0; s2 < 2; ++s2)
                    pa[s2] = (v4u){cvtpk(p[8 * s2 + 0], p[8 * s2 + 1]), cvtpk(p[8 * s2 + 2], p[8 * s2 + 3]), cvtpk(p[8 * s2 + 4], p[8 * s2 + 5]), cvtpk(p[8 * s2 + 6], p[8 * s2 + 7])};
#pragma unroll
                for (int s2 = 0; s2 < 2; ++s2) {
#pragma unroll
                    for (int d = 0; d < 4; ++d) {
                        const s16x4 lo = vtr(Vb + (32 * kb + 16 * s2) * VS + d * 64), h8 = vtr(Vb + (32 * kb + 16 * s2 + 8) * VS + d * 64);
                        const bf16x8 B = (bf16x8){lo[0], lo[1], lo[2], lo[3], h8[0], h8[1], h8[2], h8[3]};
                        o[d] = __builtin_amdgcn_mfma_f32_32x32x16_bf16(__builtin_bit_cast(bf16x8, pa[s2]), B, o[d], 0, 0, 0);
                    }
                    __builtin_amdgcn_sched_barrier(0);
                }
            }
        }
        if (more) { ATT_WRITEK(buf ^ 1); ATT_WRITEV(buf ^ 1); }
        ATT_BAR();
    }
    int lane_e = lane; asm volatile("" : "+v"(lane_e));
    const int r32e = lane_e & 31, hie = lane_e >> 5;
    LAS float* scr = (LAS float*)(L + L_SCR + w * 256);
    scr[lane_e] = lsum;
    LDS_WAIT(); asm volatile("" ::: "memory");
    LAS unsigned char* stgb = L + w * 8192 + hie * 1024 + r32e * 2;
    const LAS float* scrh = scr + 4 * hie;
#pragma unroll
    for (int r = 0; r < 16; ++r) { const float rl = __builtin_amdgcn_rcpf(scrh[(r & 3) + 8 * (r >> 2)] + scrh[32 + (r & 3) + 8 * (r >> 2)]);
#pragma unroll
        for (int d = 0; d < 4; ++d) *(LAS bf16*)(stgb + ((r & 3) + 8 * (r >> 2)) * 256 + d * 64) = (bf16)f2bf(o[d][r] * rl); }
    LDS_WAIT(); asm volatile("" ::: "memory");
    const LAS unsigned char* stg = L + w * 8192;
    const int b = bh >> 3, h = bh & 7;
    const size_t grow0 = (size_t)b * SEQ + qb * 256 + 32 * w;
    unsigned char* Yg = ws + WS_Y + (grow0 * DM + 1024 + h * VHD) * 2;
    float* SSAo = SSAarr + grow0;
    const int rowe = lane_e >> 4, ch = lane_e & 15;
#pragma unroll
    for (int i = 0; i < 8; ++i) { const int row = i * 4 + rowe;
        const v4u v = *(const LAS v4u*)(stg + lane_e * 16 + i * 1024);
        *(GAS v4u*)(Yg + ((unsigned)(rowe * DM * 2 + ch * 16) + (unsigned)(i * 4 * DM * 2))) = v;
        float s = 0.f;
#pragma unroll
        for (int e = 0; e < 4; ++e) { const float x0 = __builtin_bit_cast(float, v[e] << 16), x1 = __builtin_bit_cast(float, v[e] & 0xffff0000u); s += x0 * x0 + x1 * x1; }
        s = row16_sum(s);
        if (ch == 0) atomicAdd(SSAo + row, s); }
    ATT_BAR();
#undef ATT_LOADK
#undef ATT_LOADV
#undef ATT_WRITEK
#undef ATT_WRITEV
}
__device__ __forceinline__ float attn_negC(const Args& a, int lane) {
    float mq = 0.f, mk = 0.f;
#pragma unroll
    for (int i = 0; i < 3; ++i) { mq = fmaxf(mq, fabsf(a.in[22][lane + 64 * i])); mk = fmaxf(mk, fabsf(a.in[23][lane + 64 * i])); }
#pragma unroll
    for (int o = 1; o < 64; o <<= 1) { mq = fmaxf(mq, __shfl_xor(mq, o)); mk = fmaxf(mk, __shfl_xor(mk, o)); }
    return -(QSCALE * 192.0f * 1.0005f) * mq * mk;
}
}
struct MapId { __device__ __forceinline__ int operator()(int n) const { return n; } };
struct MapGU { int which; __device__ __forceinline__ int operator()(int n) const { return (n >> 7) * 256 + which * 128 + (n & 127); } };
struct MapWin { __device__ __forceinline__ int operator()(int n) const { if (n < 1792) return n; const int i = n - 1792; return 1792 + 2 * (i & 31) + (i >> 5); } };
struct MapQ { __device__ __forceinline__ int operator()(int n) const { const int h = n / 192, d = n - h * 192; if (d < 128) return h * 256 + d; const int i = d - 128; return h * 256 + 128 + 2 * (i & 31) + (i >> 5); } };

template <class Map>
__device__ __forceinline__ void p0_transpose_item(const float* W, int K, int N, const float* gain, const float* gain2, int gsplit, bf16* WT, Map map, LAS float* scr, int item, int lane) {
    const int nblk = N / 32, kb = item / nblk, nb = item % nblk, k0 = 64 * kb, n0 = 32 * nb;
    float tv[32];
    const float* wp = W + (size_t)(k0 + (lane >> 5)) * N + n0 + (lane & 31);
#pragma unroll
    for (int i = 0; i < 32; ++i) tv[i] = __builtin_nontemporal_load(wp + (size_t)(2 * i) * N);
#pragma unroll
    for (int i = 0; i < 32; ++i) scr[(2 * i + (lane >> 5)) * 33 + (lane & 31)] = tv[i];
    const int c = lane & 7;
    float gv[8];
#pragma unroll
    for (int e = 0; e < 8; ++e) { const int k = k0 + 8 * c + e; gv[e] = gain ? ((k < gsplit) ? gain[k] : gain2[k - gsplit]) : 1.0f; }
    LDS_WAIT(); asm volatile("" ::: "memory");
#pragma unroll
    for (int j = 0; j < 4; ++j) { const int n = (lane >> 3) + 8 * j; const LAS float* s = scr + (8 * c) * 33 + n;
        v4u o; o.x = pk2(s[0 * 33] * gv[0], s[1 * 33] * gv[1]); o.y = pk2(s[2 * 33] * gv[2], s[3 * 33] * gv[3]); o.z = pk2(s[4 * 33] * gv[4], s[5 * 33] * gv[5]); o.w = pk2(s[6 * 33] * gv[6], s[7 * 33] * gv[7]);
        *(GAS v4u*)(WT + (size_t)map(n0 + n) * K + k0 + 8 * c) = o; }
    LDS_WAIT(); asm volatile("" ::: "memory");
}
__device__ __forceinline__ void row_to_bf16_ss(const float* xrow, bf16* orow, float* ss, int lane) {
    const GAS f32x4* xr = (const GAS f32x4*)xrow + lane;
    GAS v2u* o8 = (GAS v2u*)orow + lane;
    float s = 0.f;
#pragma unroll
    for (int j = 0; j < DM / 256; ++j) { const f32x4 v = xr[64 * j]; s += (v.x * v.x + v.y * v.y) + (v.z * v.z + v.w * v.w);
        v2u w; w.x = pk2(v.x, v.y); w.y = pk2(v.z, v.w); o8[64 * j] = w; }
    s = wave_sum(s);
    if (lane == 0) *ss = s;
}

__device__ __forceinline__ void p0_prologue(Frame& F, const Args& a) {
    unsigned char* ws = a.ws;
    LAS float* scr = (LAS float*)(F.lds + RING_OFF + F.wave * 16384);
    const int gw = F.vcu * NWAVES + F.wave, NGW = F.G * NWAVES;
    const int gt = F.vcu * NWAVES * 64 + F.tid, NGT = F.G * NWAVES * 64;
    constexpr int I_GU = (DM / 64) * (DFF / 32), I_D = (DFF / 64) * (DM / 32), I_IN = (DM / 64) * (DIN / 32), I_OUT = (DM / 64) * (DM / 32), I_GLU = (SSMW / 64) * (SSMW / 32),
                  I_Q = (QL / 64) * (1536 / 32), I_KV = (KVL / 64) * (2048 / 32);
    constexpr int NITEMS = 4 * I_GU + 2 * I_D + I_IN + I_OUT + I_GLU + I_Q + I_KV;
    for (int it = gw; it < NITEMS; it += NGW) {
        int r = it;
        if (r < I_GU) { p0_transpose_item(a.in[3], DM, DFF, a.in[2], a.in[2], DM, (bf16*)(ws + WS_W1GU), MapGU{0}, scr, r, F.lane); continue; } r -= I_GU;
        if (r < I_GU) { p0_transpose_item(a.in[4], DM, DFF, a.in[2], a.in[2], DM, (bf16*)(ws + WS_W1GU), MapGU{1}, scr, r, F.lane); continue; } r -= I_GU;
        if (r < I_D)  { p0_transpose_item(a.in[5], DFF, DM, nullptr, nullptr, 0, (bf16*)(ws + WS_W1D), MapId{}, scr, r, F.lane); continue; } r -= I_D;
        if (r < I_IN) { p0_transpose_item(a.in[7], DM, DIN, a.in[6], a.in[6], DM, (bf16*)(ws + WS_WIN), MapWin{}, scr, r, F.lane); continue; } r -= I_IN;
        if (r < I_Q)  { p0_transpose_item(a.in[19], QL, 1536, a.in[18], a.in[18], QL, (bf16*)(ws + WS_WQ), MapQ{}, scr, r, F.lane); continue; } r -= I_Q;
        if (r < I_KV) { p0_transpose_item(a.in[21], KVL, 2048, a.in[20], a.in[20], KVL, (bf16*)(ws + WS_WKV), MapId{}, scr, r, F.lane); continue; } r -= I_KV;
        if (r < I_GLU) { p0_transpose_item(a.in[16], SSMW, SSMW, nullptr, nullptr, 0, (bf16*)(ws + WS_WGLU), MapId{}, scr, r, F.lane); continue; } r -= I_GLU;
        if (r < I_OUT) { p0_transpose_item(a.in[26], DM, DM, a.in[24], a.in[25], SSMW, (bf16*)(ws + WS_WOUT), MapId{}, scr, r, F.lane); continue; } r -= I_OUT;
        if (r < I_GU) { p0_transpose_item(a.in[28], DM, DFF, a.in[27], a.in[27], DM, (bf16*)(ws + WS_W2GU), MapGU{0}, scr, r, F.lane); continue; } r -= I_GU;
        if (r < I_GU) { p0_transpose_item(a.in[29], DM, DFF, a.in[27], a.in[27], DM, (bf16*)(ws + WS_W2GU), MapGU{1}, scr, r, F.lane); continue; } r -= I_GU;
        p0_transpose_item(a.in[30], DFF, DM, nullptr, nullptr, 0, (bf16*)(ws + WS_W2D), MapId{}, scr, r, F.lane);
    }
    for (int it = gw; it < NG * 64; it += NGW) s5_tab_kp_item(a, ws, scr, it, F.lane);
    for (int it = gw; it < NG * 32; it += NGW) s5_tab_r_item(a, ws, scr, it, F.lane);
    { GAS v4u* p = (GAS v4u*)(ws + WS_WIN + (size_t)DIN * DM * 2); const int n16 = (DINP - DIN) * DM * 2 / 16;
      for (int i = gt; i < n16; i += NGT) p[i] = (v4u){0u, 0u, 0u, 0u}; }
    { const int per_h = 64 * QL * 2 / 16, n16 = NH * per_h;
      for (int i = gt; i < n16; i += NGT) { const int h = i / per_h, r = i - h * per_h; ((GAS v4u*)(ws + WS_WQ + (size_t)(h * 256 + 192) * QL * 2))[r] = (v4u){0u, 0u, 0u, 0u}; } }
    float* SS = (float*)(ws + WS_SS);
    for (int m = gw; m < MT; m += NGW) row_to_bf16_ss(a.in[0] + (size_t)m * DM, (bf16*)(ws + WS_XB) + (size_t)m * DM, SS + SS1 * MT + m, F.lane);
    { const int* pos = (const int*)a.in[1]; float* CS = (float*)(ws + WS_CS); float* SN = (float*)(ws + WS_SN);
      for (int i = gt; i < MT * 32; i += NGT) { const int row = i >> 5, k = i & 31; const float inv_freq = powf(10000.0f, -(float)(2 * k) / 64.0f); const float ang = (float)pos[row] * inv_freq;
          CS[i] = cosf(ang); SN[i] = sinf(ang); } }
}

constexpr int N_PHASES = 10;
#ifndef DUP_PHASE
#define DUP_PHASE (-1)
#endif
#define REPS(k) _Pragma("unroll") for (int rep_ = (DUP_PHASE == (k)) ? 0 : 1; rep_ < 2; ++rep_)
#define SSX(arr) (((DUP_PHASE >= 0) && rep_ == 0) ? (float*)(ws + WS_TAB) + (arr) * MT : SS + (arr) * MT)
__global__ void __launch_bounds__(NWAVES * 64, 2) mk_fwd(Args args) {
    extern __shared__ __attribute__((aligned(16))) unsigned char lds[];
    Frame F;
    F.lds = (LAS unsigned char*)lds;
    F.MISC = (volatile LAS unsigned*)(F.lds + MISC_OFF);
    F.tid = threadIdx.x; F.lane = F.tid & 63; F.wave = __builtin_amdgcn_readfirstlane(F.tid >> 6);
    F.G = gridDim.x; { const int bx = blockIdx.x; F.vcu = (F.G % 8 == 0) ? (bx % 8) * (F.G / 8) + bx / 8 : bx; }
    unsigned char* ws = args.ws;
    F.ctl = (gu32*)(ws + WS_CTL);
    for (int u = F.tid; u < (LDS_BYTES - LDSCTL_OFF) / 4; u += NWAVES * 64) ((LAS unsigned*)(F.lds + LDSCTL_OFF))[u] = 0u;
    __syncthreads();
    const int lo = args.ph_lo, hi = args.ph_hi;
    const bool use_bar = (hi - lo) > 1;
    XcdBarrier bar; bar.bar = (unsigned*)(F.ctl + CW_BAR); bar.x = 0; bar.st = nullptr;
    if (use_bar) bar = xcd_barrier_post((unsigned*)(F.ctl + CW_BAR), F.MISC + 8);
#define IN(k) (lo <= (k) && (k) < hi)
#define SEAM(k) do { if (IN(k) && IN((k) + 1)) xcd_barrier(bar); } while (0)
    float* SS = (float*)(ws + WS_SS);
    bf16* XB = (bf16*)(ws + WS_XB);
    bf16* HB = (bf16*)(ws + WS_H);
    float* RS = args.out;

    if (IN(0)) { if (DUP_PHASE == 0) { p0_prologue(F, args); asm volatile("" ::: "memory"); } p0_prologue(F, args); SEAM(0); }

    if (IN(1)) {
        pg8::Gemm g{XB, (const bf16*)(ws + WS_W1GU), MT, 2 * DFF, DM}; pg8::StaticOrder S; S.init(MT, 2 * DFF, F.G, (int)blockIdx.x);
        pg8::EpiSwiGLU E{HB, DFF, SS + SS1 * MT, 1.0f / DM};
        REPS(1) pg8::gemm_phase<pg8::EpiSwiGLU, pg8::StaticOrder, true, true>(F.lds + RING_OFF, g, S, E);
        SEAM(1);
    }
    if (IN(2)) {
        pg8::Gemm g{HB, (const bf16*)(ws + WS_W1D), MT, DM, DFF}; pg8::StaticOrder S; S.init(MT, DM, F.G, (int)blockIdx.x);
        REPS(2) { pg8::EpiResid E{args.in[0], RS, XB, SSX(SS2), 0.5f, DM};
        pg8::gemm_phase<pg8::EpiResid, pg8::StaticOrder, true, true>(F.lds + RING_OFF, g, S, E); }
        SEAM(2);
    }
    if (IN(3)) {
        pg8::Gemm g{XB, (const bf16*)(ws + WS_WIN), MT, DINP, DM}; pg8::StaticOrder S; S.init(MT, DINP, F.G, (int)blockIdx.x);
        REPS(3) { pg8::EpiWin E{SS + SS2 * MT, (bf16*)(ws + WS_U), (bf16*)(ws + WS_QLAT), (bf16*)(ws + WS_KVLAT), (float*)(ws + WS_KPE), SSX(SSQ), SSX(SSKV)};
        pg8::gemm_phase<pg8::EpiWin, pg8::StaticOrder, true, true>(F.lds + RING_OFF, g, S, E); }
        SEAM(3);
    }
    if (IN(4)) {
        if (F.G == 256) REPS(4) {
            {
                pg8::Gemm g{(const bf16*)(ws + WS_QLAT), (const bf16*)(ws + WS_WQ), MT, QUPP, QL}; pg8::StaticOrder S; S.init(MT, QUPP, F.G, (int)blockIdx.x);
                pg8::EpiQ E{SS + SSQ * MT, args.in[22], (const float*)(ws + WS_CS), (const float*)(ws + WS_SN), (bf16*)(ws + WS_QH), QSCALE};
                pg8::gemm_phase<pg8::EpiQ, pg8::StaticOrder, false, true>(F.lds + RING_OFF, g, S, E);
            }
            {
                pg8::Gemm g{(const bf16*)(ws + WS_KVLAT), (const bf16*)(ws + WS_WKV), MT, KVUP, KVL}; pg8::StaticOrder S; S.init(MT, KVUP, F.G, (int)blockIdx.x);
                pg8::EpiKV E{SS + SSKV * MT, args.in[23], (const float*)(ws + WS_KPE), (const float*)(ws + WS_CS), (const float*)(ws + WS_SN), (bf16*)(ws + WS_KH), (bf16*)(ws + WS_VH)};
                pg8::gemm_phase<pg8::EpiKV, pg8::StaticOrder, false, true>(F.lds + RING_OFF, g, S, E);
            }
            s5_item(F, args, F.vcu & 3, F.vcu >> 2);
        }
        SEAM(4);
    }
    if (IN(5)) {
        if (F.G == 256) REPS(5) {
            if (F.vcu < 128) {
                const float negC = att::attn_negC(args, F.lane);
                const int bh = F.vcu >> 2, s = F.vcu & 3;
#pragma unroll 1
                for (int u2 = 0; u2 < 2; ++u2) att::attn_unit(F, args, bh, u2 ? 7 - s : s, negC, SSX(SSA));
            } else {
                pg8::Gemm g{(const bf16*)(ws + WS_YS), (const bf16*)(ws + WS_WGLU), MT, SSMW, SSMW}; pg8::StaticOrder S; S.init(MT, SSMW, 128, F.vcu - 128);
                pg8::EpiGLU E{(const bf16*)(ws + WS_YS), args.in[17], (bf16*)(ws + WS_Y), DM, SSX(SSS)};
                pg8::gemm_phase<pg8::EpiGLU, pg8::StaticOrder, true, true>(F.lds + RING_OFF, g, S, E);
            }
        }
        SEAM(5);
    }
    if (IN(6)) {
        pg8::Gemm g{(const bf16*)(ws + WS_Y), (const bf16*)(ws + WS_WOUT), MT, DM, DM}; pg8::StaticOrder S; S.init(MT, DM, F.G, (int)blockIdx.x);
        pg8::EpiWout E{SS + SSS * MT, SS + SSA * MT, RS, XB, SS + SS3 * MT, DM};
        pg8::gemm_phase<pg8::EpiWout, pg8::StaticOrder, true, true>(F.lds + RING_OFF, g, S, E);
        SEAM(6);
    }
    if (IN(7)) {
        pg8::Gemm g{XB, (const bf16*)(ws + WS_W2GU), MT, 2 * DFF, DM}; pg8::StaticOrder S; S.init(MT, 2 * DFF, F.G, (int)blockIdx.x);
        pg8::EpiSwiGLU E{HB, DFF, SS + SS3 * MT, 1.0f / DM};
        pg8::gemm_phase<pg8::EpiSwiGLU, pg8::StaticOrder, true, true>(F.lds + RING_OFF, g, S, E);
        SEAM(7);
    }
    if (IN(8)) {
        pg8::Gemm g{HB, (const bf16*)(ws + WS_W2D), MT, DM, DFF}; pg8::StaticOrder S; S.init(MT, DM, F.G, (int)blockIdx.x);
        pg8::EpiResid E{RS, RS, nullptr, SS + SS4 * MT, 0.5f, DM};
        pg8::gemm_phase<pg8::EpiResid, pg8::StaticOrder, true, true>(F.lds + RING_OFF, g, S, E);
        SEAM(8);
    }
    if (IN(9)) {
        const int gw = F.vcu * NWAVES + F.wave, NGW = F.G * NWAVES;
        const float* gfin = args.in[31];
        for (int m = gw; m < MT; m += NGW) {
            const float rs = rsqrtf(SS[SS4 * MT + m] * (1.0f / DM) + EPS);
            GAS f32x4* p = (GAS f32x4*)(RS + (size_t)m * DM) + F.lane;
#pragma unroll
            for (int j = 0; j < DM / 256; ++j) { const f32x4 v = p[64 * j]; const f32x4 gg = ((const GAS f32x4*)gfin)[64 * j + F.lane]; p[64 * j] = v * gg * rs; }
        }
    }
#undef IN
#undef SEAM
}

#ifndef MK_N_LAUNCHES
#define MK_N_LAUNCHES 1
#endif
extern "C" void kernel_launch(void* const* d_in, const int* in_sizes, int n_in, void* d_out, int out_size, void* d_ws, size_t ws_size, hipStream_t stream) {
    static int grid = 0;
    if (grid == 0) {
        if (n_in != 32 || out_size != MT * DM || ws_size < WS_END) { fprintf(stderr, "kernel_launch: unexpected shapes / workspace (n_in %d out %d ws %zu need %zu)\n", n_in, out_size, ws_size, (size_t)WS_END); grid = -1; return; }
        int dev = 0, cus = 0;
        if (hipGetDevice(&dev) != hipSuccess || hipDeviceGetAttribute(&cus, hipDeviceAttributeMultiprocessorCount, dev) != hipSuccess) { grid = -1; return; }
        if (hipFuncSetAttribute((const void*)mk_fwd, hipFuncAttributeMaxDynamicSharedMemorySize, LDS_BYTES) != hipSuccess) { fprintf(stderr, "kernel_launch: hipFuncSetAttribute failed\n"); grid = -1; return; }
        int per_cu = 0;
        if (hipOccupancyMaxActiveBlocksPerMultiprocessor(&per_cu, (const void*)mk_fwd, NWAVES * 64, LDS_BYTES) != hipSuccess || per_cu < 1)
            fprintf(stderr, "kernel_launch: note: occupancy query reports %d workgroups per CU\n", per_cu);
        (void)hipGetLastError();
        grid = cus;
        if (grid != 256) { fprintf(stderr, "kernel_launch: built for a 256-CU device (got %d)\n", grid); grid = -1; return; }
    }
    if (grid < 0) return;
    (void)hipMemsetAsync((char*)d_ws + WS_CTL, 0, CTL_ZERO_BYTES, stream);
    Args a{};
    for (int i = 0; i < 32; ++i) a.in[i] = (const float*)d_in[i];
    a.out = (float*)d_out; a.ws = (unsigned char*)d_ws;
    if (MK_N_LAUNCHES == 1) {
        a.ph_lo = 0; a.ph_hi = N_PHASES;
        hipLaunchKernelGGL(mk_fwd, dim3(grid), dim3(NWAVES * 64), LDS_BYTES, stream, a);
    } else {
        for (int p = 0; p < N_PHASES; ++p) { a.ph_lo = p; a.ph_hi = p + 1; hipLaunchKernelGGL(mk_fwd, dim3(grid), dim3(NWAVES * 64), LDS_BYTES, stream, a); }
    }
}
```
